# Optimizing an MI355X kernel written in HIP

```python
import math
import jax, jax.numpy as jnp
from jax import lax
import numpy as np

D_MODEL = 1024
BATCH = 8
SEQ = 2048
DEPTH = 2

CHUNK = 64
N_META = 16
S5_WIDTH = D_MODEL // 2
S5_GROUP = 16
S5_GROUPS = S5_WIDTH // S5_GROUP
S5_STATE = 64
S5_DT_MIN = 1e-3
S5_DT_MAX = 1e-1
DA_HEADS = 4
DA_HEAD_DIM = 64
DA_WIDTH = DA_HEADS * 2 * DA_HEAD_DIM
Q_BLOCK = 128
D_RNN = 1280
LRU_BLOCKS = 10
LRU_BLOCK_W = D_RNN // LRU_BLOCKS
CONV_WIDTH = 4
LRU_C = 8.0
N_GROUPS = 4
EXPERTS_PER_GROUP = 8
N_EXPERTS = N_GROUPS * EXPERTS_PER_GROUP
TOP_K_FINE = 2
D_EXPERT = 512
EXPERT_BLOCK = 128
ALPHA = (2 * DEPTH) ** 0.25
BETA = (8 * DEPTH) ** -0.25
LN_EPS = 1e-5
NEG_INF = -1e30

kernel_name = "hybrid_s5_diffattn_rglru_hmoe_block"

F32 = jnp.float32


def _layer_norm(z, g, b):
    zf = z.astype(F32)
    mu = jnp.mean(zf, -1, keepdims=True)
    var = jnp.mean(jnp.square(zf - mu), -1, keepdims=True)
    return (zf - mu) * lax.rsqrt(var + LN_EPS) * g.astype(F32) + b.astype(F32)


def _complex_linear_combine(e1, e2):
    a1r, a1i, b1r, b1i = e1
    a2r, a2i, b2r, b2i = e2
    return (a2r * a1r - a2i * a1i, a2r * a1i + a2i * a1r,
            a2r * b1r - a2i * b1i + b2r, a2r * b1i + a2i * b1r + b2i)


def _real_linear_combine(e1, e2):
    a1, b1 = e1
    a2, b2 = e2
    return (a2 * a1, a2 * b1 + b2)


def _s5(u, lam_re, lam_im, log_dt, b_re, b_im, c_re, c_im, d, w_glu, b_glu):
    bsz, L, _ = u.shape
    ug = u.reshape(bsz, L, S5_GROUPS, S5_GROUP)
    dt = jnp.exp(log_dt.astype(F32))[:, None]
    lr = jnp.minimum(lam_re.astype(F32), -1e-4)
    li = lam_im.astype(F32)
    mag = jnp.exp(lr * dt)
    ar = mag * jnp.cos(li * dt)
    ai = mag * jnp.sin(li * dt)
    den = lr * lr + li * li
    nr, ni = ar - 1.0, ai
    fr = ((nr * lr + ni * li) / den)[..., None]
    fi = ((ni * lr - nr * li) / den)[..., None]
    br, bi = b_re.astype(F32), b_im.astype(F32)
    bbr = fr * br - fi * bi
    bbi = fr * bi + fi * br
    bur = jnp.einsum('blgh,gph->blgp', ug, bbr)
    bui = jnp.einsum('blgh,gph->blgp', ug, bbi)
    a_r = jnp.broadcast_to(ar, (1, L, S5_GROUPS, S5_STATE))
    a_i = jnp.broadcast_to(ai, (1, L, S5_GROUPS, S5_STATE))
    _, _, hr, hi = lax.associative_scan(_complex_linear_combine, (a_r, a_i, bur, bui), axis=1)
    y = (jnp.einsum('blgp,ghp->blgh', hr, c_re.astype(F32))
         - jnp.einsum('blgp,ghp->blgh', hi, c_im.astype(F32)))
    y = y.reshape(bsz, L, S5_WIDTH) + d.astype(F32) * u
    y = jax.nn.gelu(y)
    return y * jax.nn.sigmoid(y @ w_glu.astype(F32) + b_glu.astype(F32))


def _diff_attention(q, k, v, lq1, lk1, lq2, lk2, subln_g, lam_init):
    bsz, L = q.shape[:2]
    Lp = -(-L // Q_BLOCK) * Q_BLOCK
    nqb = Lp // Q_BLOCK
    pad = Lp - L
    padw = lambda t: jnp.pad(t, ((0, 0), (0, pad)) + ((0, 0),) * (t.ndim - 2))
    q, k, v = padw(q), padw(k), padw(v)
    pos = jnp.arange(Lp)
    cid = jnp.where(pos < N_META, 0, 1 + (pos - N_META) // CHUNK)
    cid = jnp.where(pos < L, cid, Lp)
    lam = (jnp.exp(jnp.sum(lq1.astype(F32) * lk1.astype(F32)))
           - jnp.exp(jnp.sum(lq2.astype(F32) * lk2.astype(F32))) + lam_init)
    scale = DA_HEAD_DIM ** -0.5
    qb = q.reshape(bsz, nqb, Q_BLOCK, DA_HEADS, 2, DA_HEAD_DIM).transpose(1, 0, 2, 3, 4, 5)
    cqb = cid.reshape(nqb, Q_BLOCK)

    def block(args):
        q_blk, c_blk = args
        s = jnp.einsum('bqhcd,bkhcd->bchqk', q_blk, k) * scale
        mask = cid[None, :] <= c_blk[:, None]
        p = jax.nn.softmax(jnp.where(mask, s, NEG_INF), axis=-1)
        w = p[:, 0] - lam * p[:, 1]
        return jnp.einsum('bhqk,bkhe->bqhe', w, v)

    o = lax.map(block, (qb, cqb))
    o = o.transpose(1, 0, 2, 3, 4).reshape(bsz, Lp, DA_HEADS, 2 * DA_HEAD_DIM)[:, :L]
    o = o * lax.rsqrt(jnp.mean(o * o, -1, keepdims=True) + LN_EPS) * subln_g.astype(F32)
    return (o * (1.0 - lam_init)).reshape(bsz, L, DA_WIDTH)


def _s5_diffattn_mixer(h, w_in, lam_re, lam_im, log_dt, b_re, b_im, c_re, c_im, d, w_glu, b_glu,
                       lq1, lk1, lq2, lk2, subln_g, w_out, lam_init):
    bsz, L, _ = h.shape
    z = (h @ w_in).astype(F32)
    u = z[..., :S5_WIDTH]
    o = S5_WIDTH
    q = z[..., o:o + DA_WIDTH].reshape(bsz, L, DA_HEADS, 2, DA_HEAD_DIM)
    k = z[..., o + DA_WIDTH:o + 2 * DA_WIDTH].reshape(bsz, L, DA_HEADS, 2, DA_HEAD_DIM)
    v = z[..., o + 2 * DA_WIDTH:].reshape(bsz, L, DA_HEADS, 2 * DA_HEAD_DIM)
    y_s5 = _s5(u, lam_re, lam_im, log_dt, b_re, b_im, c_re, c_im, d, w_glu, b_glu)
    y_da = _diff_attention(q, k, v, lq1, lk1, lq2, lk2, subln_g, lam_init)
    return jnp.concatenate([y_s5, y_da], axis=-1) @ w_out.astype(F32)


def _rglru_mixer(h, w_in, conv_w, conv_b, w_a, b_a, w_x, b_x, lru_lambda, w_out):
    bsz, L, _ = h.shape
    z = (h @ w_in).astype(F32)
    gate_br, rec = z[..., :D_RNN], z[..., D_RNN:]
    rp = jnp.pad(rec, ((0, 0), (CONV_WIDTH - 1, 0), (0, 0)))
    cw = conv_w.astype(F32)
    xc = sum(rp[:, j:j + L] * cw[j] for j in range(CONV_WIDTH)) + conv_b.astype(F32)
    xb = xc.reshape(bsz, L, LRU_BLOCKS, LRU_BLOCK_W)
    r = jax.nn.sigmoid(jnp.einsum('blnd,nde->blne', xb, w_a.astype(F32))
                       + b_a.astype(F32).reshape(LRU_BLOCKS, LRU_BLOCK_W))
    ig = jax.nn.sigmoid(jnp.einsum('blnd,nde->blne', xb, w_x.astype(F32))
                        + b_x.astype(F32).reshape(LRU_BLOCKS, LRU_BLOCK_W))
    log_a = -LRU_C * r * jax.nn.softplus(-lru_lambda.astype(F32).reshape(LRU_BLOCKS, LRU_BLOCK_W))
    a = jnp.exp(log_a)
    bterm = jnp.sqrt(-jnp.expm1(2.0 * log_a)) * (ig * xb)
    _, hs = lax.associative_scan(_real_linear_combine, (a, bterm), axis=1)
    y = jax.nn.gelu(gate_br) * hs.reshape(bsz, L, D_RNN)
    return y @ w_out.astype(F32)


def _hier_moe(h, w_coarse, b_coarse, w_fine, b_fine, w_gate, w_up, w_down):
    bsz, L, d = h.shape
    x2 = h.reshape(-1, d)
    T = x2.shape[0]
    xf = x2.astype(F32)
    coarse = xf @ w_coarse.astype(F32) + b_coarse.astype(F32)
    p_coarse = jax.nn.softmax(coarse, axis=-1)
    grp = jnp.argmax(coarse, axis=-1)
    p_grp = jnp.take_along_axis(p_coarse, grp[:, None], axis=1)
    fine_all = jnp.einsum('td,gde->tge', xf, w_fine.astype(F32)) + b_fine.astype(F32)
    fine = jnp.take_along_axis(fine_all, grp[:, None, None], axis=1)[:, 0]
    top_v, top_i = lax.top_k(fine, TOP_K_FINE)
    gates = p_grp * jax.nn.softmax(top_v, axis=-1)
    experts = grp[:, None] * EXPERTS_PER_GROUP + top_i
    n_assign = T * TOP_K_FINE
    nb = -(-(n_assign + N_EXPERTS * (EXPERT_BLOCK - 1)) // EXPERT_BLOCK)
    e_flat = experts.reshape(-1)
    tok_flat = jnp.repeat(jnp.arange(T), TOP_K_FINE)
    g_flat = gates.reshape(-1)
    order = jnp.argsort(e_flat)
    e_s, tok_s, g_s = e_flat[order], tok_flat[order], g_flat[order]
    counts = jnp.bincount(e_flat, length=N_EXPERTS)
    padded = (counts + EXPERT_BLOCK - 1) // EXPERT_BLOCK * EXPERT_BLOCK
    pad_end = jnp.cumsum(padded)
    pad_start = pad_end - padded
    raw_start = jnp.cumsum(counts) - counts
    dest = pad_start[e_s] + jnp.arange(n_assign) - raw_start[e_s]
    slot_tok = jnp.full((nb * EXPERT_BLOCK,), T, jnp.int32).at[dest].set(tok_s)
    slot_gate = jnp.zeros((nb * EXPERT_BLOCK,), F32).at[dest].set(g_s)
    block_expert = jnp.minimum(
        jnp.searchsorted(pad_end, jnp.arange(nb) * EXPERT_BLOCK, side='right'), N_EXPERTS - 1)
    x_ext = jnp.concatenate([x2, jnp.zeros((1, d), x2.dtype)], axis=0)
    xb = x_ext[slot_tok].reshape(nb, EXPERT_BLOCK, d)

    def expert_block(args):
        xblk, e = args
        hid = jax.nn.silu(xblk @ w_gate[e]) * (xblk @ w_up[e])
        return hid @ w_down[e]

    yb = lax.map(expert_block, (xb, block_expert)).reshape(-1, d)
    y = jnp.zeros((T + 1, d), F32).at[slot_tok].add(yb.astype(F32) * slot_gate[:, None])
    return y[:T].reshape(bsz, L, d)


def setup_inputs(seed: int = 0) -> dict:
    key = jax.random.key(seed)
    keys = iter(jax.random.split(key, 64))
    nrm = lambda shape, scale: jax.random.normal(next(keys), shape, F32) * scale
    p = {}
    p['x'] = nrm((BATCH, SEQ, D_MODEL), 1.0)
    p['meta'] = nrm((N_META, D_MODEL), 1.0)

    def ln(prefix):
        p[prefix + '_g'] = 1.0 + nrm((D_MODEL,), 0.02)
        p[prefix + '_b'] = nrm((D_MODEL,), 0.02)

    def moe(prefix):
        p[prefix + '_w_coarse'] = nrm((D_MODEL, N_GROUPS), D_MODEL ** -0.5)
        p[prefix + '_b_coarse'] = nrm((N_GROUPS,), 0.01)
        p[prefix + '_w_fine'] = nrm((N_GROUPS, D_MODEL, EXPERTS_PER_GROUP), D_MODEL ** -0.5)
        p[prefix + '_b_fine'] = nrm((N_GROUPS, EXPERTS_PER_GROUP), 0.01)
        p[prefix + '_w_gate'] = nrm((N_EXPERTS, D_MODEL, D_EXPERT), D_MODEL ** -0.5)
        p[prefix + '_w_up'] = nrm((N_EXPERTS, D_MODEL, D_EXPERT), D_MODEL ** -0.5)
        p[prefix + '_w_down'] = nrm((N_EXPERTS, D_EXPERT, D_MODEL), D_EXPERT ** -0.5 * BETA)

    ln('l0_ln1')
    p['l0_w_in'] = nrm((D_MODEL, S5_WIDTH + 3 * DA_WIDTH), D_MODEL ** -0.5)
    p['l0_s5_lambda_re'] = -0.5 + nrm((S5_GROUPS, S5_STATE), 0.01)
    p['l0_s5_lambda_im'] = math.pi * jnp.arange(S5_STATE, dtype=F32)[None, :] + nrm((S5_GROUPS, S5_STATE), 0.01)
    p['l0_s5_log_dt'] = jax.random.uniform(next(keys), (S5_GROUPS,), F32, math.log(S5_DT_MIN), math.log(S5_DT_MAX))
    p['l0_s5_b_re'] = nrm((S5_GROUPS, S5_STATE, S5_GROUP), (2 * S5_GROUP) ** -0.5)
    p['l0_s5_b_im'] = nrm((S5_GROUPS, S5_STATE, S5_GROUP), (2 * S5_GROUP) ** -0.5)
    p['l0_s5_c_re'] = nrm((S5_GROUPS, S5_GROUP, S5_STATE), (2 * S5_STATE) ** -0.5)
    p['l0_s5_c_im'] = nrm((S5_GROUPS, S5_GROUP, S5_STATE), (2 * S5_STATE) ** -0.5)
    p['l0_s5_d'] = nrm((S5_WIDTH,), 1.0)
    p['l0_s5_w_glu'] = nrm((S5_WIDTH, S5_WIDTH), S5_WIDTH ** -0.5)
    p['l0_s5_b_glu'] = nrm((S5_WIDTH,), 0.02)
    p['l0_da_lq1'] = nrm((DA_HEAD_DIM,), 0.1)
    p['l0_da_lk1'] = nrm((DA_HEAD_DIM,), 0.1)
    p['l0_da_lq2'] = nrm((DA_HEAD_DIM,), 0.1)
    p['l0_da_lk2'] = nrm((DA_HEAD_DIM,), 0.1)
    p['l0_da_subln_g'] = 1.0 + nrm((2 * DA_HEAD_DIM,), 0.02)
    p['l0_w_out'] = nrm((S5_WIDTH + DA_WIDTH, D_MODEL), (S5_WIDTH + DA_WIDTH) ** -0.5 * BETA)
    ln('l0_ln2')
    moe('l0_moe')
    ln('l1_ln1')
    p['l1_w_in'] = nrm((D_MODEL, 2 * D_RNN), D_MODEL ** -0.5)
    p['l1_conv_w'] = nrm((CONV_WIDTH, D_RNN), CONV_WIDTH ** -0.5)
    p['l1_conv_b'] = nrm((D_RNN,), 0.02)
    p['l1_lru_w_a'] = nrm((LRU_BLOCKS, LRU_BLOCK_W, LRU_BLOCK_W), LRU_BLOCK_W ** -0.5)
    p['l1_lru_b_a'] = nrm((D_RNN,), 0.02)
    p['l1_lru_w_x'] = nrm((LRU_BLOCKS, LRU_BLOCK_W, LRU_BLOCK_W), LRU_BLOCK_W ** -0.5)
    p['l1_lru_b_x'] = nrm((D_RNN,), 0.02)
    a_c = jax.random.uniform(next(keys), (D_RNN,), F32, 0.9, 0.999)
    s = a_c ** (1.0 / LRU_C)
    p['l1_lru_lambda'] = jnp.log(s) - jnp.log1p(-s)
    p['l1_w_out'] = nrm((D_RNN, D_MODEL), D_RNN ** -0.5 * BETA)
    ln('l1_ln2')
    moe('l1_moe')
    return p


def reference(x, meta,
              l0_ln1_g, l0_ln1_b, l0_w_in, l0_s5_lambda_re, l0_s5_lambda_im, l0_s5_log_dt,
              l0_s5_b_re, l0_s5_b_im, l0_s5_c_re, l0_s5_c_im, l0_s5_d, l0_s5_w_glu, l0_s5_b_glu,
              l0_da_lq1, l0_da_lk1, l0_da_lq2, l0_da_lk2, l0_da_subln_g, l0_w_out,
              l0_ln2_g, l0_ln2_b, l0_moe_w_coarse, l0_moe_b_coarse, l0_moe_w_fine, l0_moe_b_fine,
              l0_moe_w_gate, l0_moe_w_up, l0_moe_w_down,
              l1_ln1_g, l1_ln1_b, l1_w_in, l1_conv_w, l1_conv_b, l1_lru_w_a, l1_lru_b_a,
              l1_lru_w_x, l1_lru_b_x, l1_lru_lambda, l1_w_out,
              l1_ln2_g, l1_ln2_b, l1_moe_w_coarse, l1_moe_b_coarse, l1_moe_w_fine, l1_moe_b_fine,
              l1_moe_w_gate, l1_moe_w_up, l1_moe_w_down):
    dt = x.dtype
    bsz = x.shape[0]
    h = jnp.concatenate([jnp.broadcast_to(meta[None].astype(dt), (bsz, N_META, D_MODEL)), x], axis=1)
    mixers = [
        (l0_w_in, l0_s5_lambda_re, l0_s5_lambda_im, l0_s5_log_dt, l0_s5_b_re, l0_s5_b_im,
         l0_s5_c_re, l0_s5_c_im, l0_s5_d, l0_s5_w_glu, l0_s5_b_glu,
         l0_da_lq1, l0_da_lk1, l0_da_lq2, l0_da_lk2, l0_da_subln_g, l0_w_out),
        (l1_w_in, l1_conv_w, l1_conv_b, l1_lru_w_a, l1_lru_b_a, l1_lru_w_x, l1_lru_b_x,
         l1_lru_lambda, l1_w_out),
    ]
    norms = [((l0_ln1_g, l0_ln1_b), (l0_ln2_g, l0_ln2_b)),
             ((l1_ln1_g, l1_ln1_b), (l1_ln2_g, l1_ln2_b))]
    moes = [(l0_moe_w_coarse, l0_moe_b_coarse, l0_moe_w_fine, l0_moe_b_fine,
             l0_moe_w_gate, l0_moe_w_up, l0_moe_w_down),
            (l1_moe_w_coarse, l1_moe_b_coarse, l1_moe_w_fine, l1_moe_b_fine,
             l1_moe_w_gate, l1_moe_w_up, l1_moe_w_down)]
    for i in range(DEPTH):
        if i % 2 == 0:
            lam_init = 0.8 - 0.6 * math.exp(-0.3 * i)
            mix = _s5_diffattn_mixer(h, *mixers[i], lam_init=lam_init)
        else:
            mix = _rglru_mixer(h, *mixers[i])
        h = _layer_norm(ALPHA * h + mix, *norms[i][0]).astype(dt)
        h = _layer_norm(ALPHA * h + _hier_moe(h, *moes[i]), *norms[i][1]).astype(dt)
    return h[:, N_META:]
```

```cpp
#include <hip/hip_runtime.h>
#include <cstdint>
#include <cstdio>
#include <cmath>

constexpr int D = 1024, NB = 8, SEQ = 2048, NMETA = 16;
constexpr int MX = NB * SEQ;
constexpr int MR = MX + NMETA;
constexpr int MA = MX + 256;
constexpr int NZ0 = 2048, NZ1 = 2560, DRNN = 1280;
constexpr float ALPHA = 1.4142135623730951f;
constexpr float LN_EPS = 1e-5f;
constexpr float QSCALE = 0.125f * 1.4426950408889634f;
constexpr float LAM_INIT = 0.2f;
constexpr int NE = 32;
constexpr int LIST_CAP = MR;
constexpr int SLOT_CAP = 40960;

typedef unsigned short bf16;
__device__ __forceinline__ float bf2f(bf16 v) { return __uint_as_float(((unsigned)v) << 16); }
__device__ __forceinline__ bf16 f2bf(float f) { unsigned u = __float_as_uint(f); return (bf16)((u + 0x7fffu + ((u >> 16) & 1u)) >> 16); }

constexpr size_t MiB = 1u << 20;
constexpr size_t WS_CTL = 0;
constexpr size_t WS_ROUTE = 1 * MiB;
constexpr size_t WS_GATE = WS_ROUTE + 2 * MiB + 512 * 1024;
constexpr size_t WS_EBASE = WS_ROUTE + 3 * MiB - 1024;
constexpr size_t WS_WB = 4 * MiB;
constexpr size_t WS_MOE0 = 28 * MiB;
constexpr size_t WS_MOE1 = 124 * MiB;
constexpr size_t WS_R1 = 220 * MiB;
constexpr size_t WS_Z = 253 * MiB;
constexpr size_t WS_YP = 335 * MiB;
constexpr size_t WS_YM = 352 * MiB;
constexpr size_t WS_HB = 393 * MiB;
constexpr size_t WS_END = 426 * MiB;
constexpr int CW_CNT0 = 1024, CW_CNT1 = 1024 + 64;

struct P {
    const float* in[50];
    float* out;
    unsigned char* ws;
};
enum { I_X = 0, I_META, I_L0LN1G, I_L0LN1B, I_L0WIN, I_LRE, I_LIM, I_LOGDT, I_BRE, I_BIM, I_CRE, I_CIM, I_S5D, I_WGLU, I_BGLU,
       I_LQ1, I_LK1, I_LQ2, I_LK2, I_SUBLN, I_L0WOUT, I_L0LN2G, I_L0LN2B, I_M0WC, I_M0BC, I_M0WF, I_M0BF, I_M0WG, I_M0WU, I_M0WD,
       I_L1LN1G, I_L1LN1B, I_L1WIN, I_CONVW, I_CONVB, I_WA, I_BA, I_WX, I_BX, I_LAM, I_L1WOUT, I_L1LN2G, I_L1LN2B,
       I_M1WC, I_M1BC, I_M1WF, I_M1BF, I_M1WG, I_M1WU, I_M1WD };

__device__ __forceinline__ float gelu_tanh(float x) {
    const float c = 0.7978845608028654f;
    float u = c * (x + 0.044715f * x * x * x);
    return 0.5f * x * (1.f + tanhf(u));
}
__device__ __forceinline__ float sigmoidf_(float x) { return 1.f / (1.f + expf(-x)); }
__device__ __forceinline__ float wave_sum(float v) {
#pragma unroll
    for (int o = 1; o < 64; o <<= 1) v += __shfl_xor(v, o);
    return v;
}
__device__ __forceinline__ float wave_max(float v) {
#pragma unroll
    for (int o = 1; o < 64; o <<= 1) v = fmaxf(v, __shfl_xor(v, o));
    return v;
}

__global__ void n_h0(P p) {
    bf16* H0b = (bf16*)(p.ws + WS_R1);
    size_t i = (size_t)blockIdx.x * blockDim.x + threadIdx.x;
    if (i >= (size_t)MR * D) return;
    size_t r = i / D, c = i % D;
    float v = r < MX ? p.in[I_X][i] : p.in[I_META][(r - MX) * D + c];
    H0b[i] = f2bf(v);
}

template <class E, bool DUAL>
__global__ void __launch_bounds__(256) n_gemm(P p, E e) {
    __shared__ float As[16][65];
    __shared__ float Ws[16][65];
    __shared__ float Ws2[DUAL ? 16 : 1][65];
    int M, N, K, lda, ldw; const bf16* A; const float* W; const float* W2;
    if (!e.setup(p, blockIdx.z, M, N, K, A, lda, W, W2, ldw)) return;
    const int m0 = blockIdx.y * 64, n0 = blockIdx.x * 64;
    if (m0 >= M || n0 >= N) return;
    const int tx = threadIdx.x & 15, ty = threadIdx.x >> 4;
    float acc[4][4] = {}, acc2[4][4] = {};
    for (int k0 = 0; k0 < K; k0 += 16) {
        for (int i = threadIdx.x; i < 64 * 16; i += 256) {
            int mm = i >> 4, kk = i & 15; int m = m0 + mm;
            float v = 0.f;
            if (m < M) { long ar = e.arow(p, blockIdx.z, m); v = bf2f(A[(size_t)ar * lda + k0 + kk]); }
            As[kk][mm] = v;
        }
        for (int i = threadIdx.x; i < 64 * 16; i += 256) {
            int kk = i >> 6, nn = i & 63;
            Ws[kk][nn] = W[(size_t)(k0 + kk) * ldw + n0 + nn];
            if (DUAL) Ws2[kk][nn] = W2[(size_t)(k0 + kk) * ldw + n0 + nn];
        }
        __syncthreads();
#pragma unroll
        for (int kk = 0; kk < 16; ++kk) {
            float a[4], b[4], b2[4];
#pragma unroll
            for (int i = 0; i < 4; ++i) { a[i] = As[kk][ty * 4 + i]; b[i] = Ws[kk][tx * 4 + i]; b2[i] = DUAL ? Ws2[kk][tx * 4 + i] : 0.f; }
#pragma unroll
            for (int i = 0; i < 4; ++i)
#pragma unroll
                for (int j = 0; j < 4; ++j) { acc[i][j] += a[i] * b[j]; if (DUAL) acc2[i][j] += a[i] * b2[j]; }
        }
        __syncthreads();
    }
#pragma unroll
    for (int i = 0; i < 4; ++i)
#pragma unroll
        for (int j = 0; j < 4; ++j) {
            int m = m0 + ty * 4 + i, n = n0 + tx * 4 + j;
            if (m < M) e.store(p, blockIdx.z, m, n, acc[i][j], acc2[i][j]);
        }
}

struct EZ0 {
    __device__ bool setup(const P& p, int z, int& M, int& N, int& K, const bf16*& A, int& lda, const float*& W, const float*& W2, int& ldw) const {
        M = MR; N = NZ0; K = D; A = (const bf16*)(p.ws + WS_R1); lda = D; W = p.in[I_L0WIN]; W2 = nullptr; ldw = NZ0; return true; }
    __device__ long arow(const P&, int, int m) const { return m; }
    __device__ void store(const P& p, int, int m, int n, float v, float) const {
        bf16* Z = (bf16*)(p.ws + WS_Z); if (n >= 512 && n < 1024) v *= QSCALE; Z[(size_t)m * NZ0 + n] = f2bf(v); }
};
struct EGLU {
    __device__ bool setup(const P& p, int z, int& M, int& N, int& K, const bf16*& A, int& lda, const float*& W, const float*& W2, int& ldw) const {
        M = MR; N = 512; K = 512; A = (const bf16*)(p.ws + WS_YP); lda = 512; W = p.in[I_WGLU]; W2 = nullptr; ldw = 512; return true; }
    __device__ long arow(const P&, int, int m) const { return m; }
    __device__ void store(const P& p, int, int m, int n, float v, float) const {
        const bf16* YP = (const bf16*)(p.ws + WS_YP); bf16* YM = (bf16*)(p.ws + WS_YM);
        float y = bf2f(YP[(size_t)m * 512 + n]); YM[(size_t)m * D + n] = f2bf(y * sigmoidf_(v + p.in[I_BGLU][n])); }
};
struct EOUT0 {
    __device__ bool setup(const P& p, int z, int& M, int& N, int& K, const bf16*& A, int& lda, const float*& W, const float*& W2, int& ldw) const {
        M = MR; N = D; K = D; A = (const bf16*)(p.ws + WS_YM); lda = D; W = p.in[I_L0WOUT]; W2 = nullptr; ldw = D; return true; }
    __device__ long arow(const P&, int, int m) const { return m; }
    __device__ void store(const P& p, int, int m, int n, float v, float) const {
        bf16* R1 = (bf16*)(p.ws + WS_R1);
        float h0 = m < MX ? p.in[I_X][(size_t)m * D + n] : p.in[I_META][(size_t)(m - MX) * D + n];
        R1[(size_t)m * D + n] = f2bf(ALPHA * h0 + v); }
};
template <int L> struct EMOE1 {
    __device__ bool setup(const P& p, int z, int& M, int& N, int& K, const bf16*& A, int& lda, const float*& W, const float*& W2, int& ldw) const {
        const int* cnt = (const int*)(p.ws + WS_CTL) + (L ? CW_CNT1 : CW_CNT0);
        M = cnt[z]; N = 512; K = D; A = (const bf16*)(p.ws + WS_HB); lda = D;
        W = p.in[L ? I_M1WG : I_M0WG] + (size_t)z * D * 512; W2 = p.in[L ? I_M1WU : I_M0WU] + (size_t)z * D * 512; ldw = 512; return M > 0; }
    __device__ long arow(const P& p, int z, int m) const { const int* list = (const int*)(p.ws + WS_ROUTE); return list[(size_t)z * LIST_CAP + m] >> 1; }
    __device__ void store(const P& p, int z, int m, int n, float g, float u) const {
        const int* ebase = (const int*)(p.ws + WS_EBASE);
        bf16* HID = (bf16*)(p.ws + WS_YM);
        float s = g / (1.f + expf(-g));
        HID[(size_t)(ebase[z] + m) * 512 + n] = f2bf(s * u); }
};
template <int L> struct EMOE2 {
    __device__ bool setup(const P& p, int z, int& M, int& N, int& K, const bf16*& A, int& lda, const float*& W, const float*& W2, int& ldw) const {
        const int* cnt = (const int*)(p.ws + WS_CTL) + (L ? CW_CNT1 : CW_CNT0);
        M = cnt[z]; N = D; K = 512; A = (const bf16*)(p.ws + WS_YM); lda = 512;
        W = p.in[L ? I_M1WD : I_M0WD] + (size_t)z * 512 * D; W2 = nullptr; ldw = D; return M > 0; }
    __device__ long arow(const P& p, int z, int m) const { const int* ebase = (const int*)(p.ws + WS_EBASE); return ebase[z] + m; }
    __device__ void store(const P& p, int z, int m, int n, float v, float) const {
        const int* list = (const int*)(p.ws + WS_ROUTE); const float* gate = (const float*)(p.ws + WS_GATE);
        int asg = list[(size_t)z * LIST_CAP + m];
        bf16* Y2 = (bf16*)(p.ws + WS_Z);
        Y2[(size_t)asg * D + n] = f2bf(v * gate[asg]); }
};
struct EZ1 {
    __device__ bool setup(const P& p, int z, int& M, int& N, int& K, const bf16*& A, int& lda, const float*& W, const float*& W2, int& ldw) const {
        M = MR; N = NZ1; K = D; A = (const bf16*)(p.ws + WS_HB); lda = D; W = p.in[I_L1WIN]; W2 = nullptr; ldw = NZ1; return true; }
    __device__ long arow(const P&, int, int m) const { return m; }
    __device__ void store(const P& p, int, int m, int n, float v, float) const {
        bf16* Z = (bf16*)(p.ws + WS_Z);
        if (n < DRNN) Z[(size_t)m * NZ1 + n] = f2bf(gelu_tanh(v)); else Z[(size_t)m * NZ1 + n] = f2bf(v); }
};
struct EOUT1 {
    __device__ bool setup(const P& p, int z, int& M, int& N, int& K, const bf16*& A, int& lda, const float*& W, const float*& W2, int& ldw) const {
        M = MR; N = D; K = DRNN; A = (const bf16*)(p.ws + WS_YM); lda = DRNN; W = p.in[I_L1WOUT]; W2 = nullptr; ldw = D; return true; }
    __device__ long arow(const P&, int, int m) const { return m; }
    __device__ void store(const P& p, int, int m, int n, float v, float) const {
        bf16* R1 = (bf16*)(p.ws + WS_R1); const bf16* Hb = (const bf16*)(p.ws + WS_HB);
        R1[(size_t)m * D + n] = f2bf(ALPHA * bf2f(Hb[(size_t)m * D + n]) + v); }
};

__global__ void __launch_bounds__(64) n_s5(P p) {
    const int b = blockIdx.x >> 5, g = blockIdx.x & 31, lane = threadIdx.x;
    const bf16* Z = (const bf16*)(p.ws + WS_Z); bf16* YP = (bf16*)(p.ws + WS_YP);
    __shared__ float su[16], shr[64], shi[64], scre[16][64], scim[16][64];
    for (int i = lane; i < 1024; i += 64) { scre[i >> 6][i & 63] = p.in[I_CRE][(size_t)g * 1024 + i]; scim[i >> 6][i & 63] = p.in[I_CIM][(size_t)g * 1024 + i]; }
    const float dt = expf(p.in[I_LOGDT][g]);
    const float lr = fminf(p.in[I_LRE][g * 64 + lane], -1e-4f), li = p.in[I_LIM][g * 64 + lane];
    const float mag = expf(lr * dt), ar = mag * cosf(li * dt), ai = mag * sinf(li * dt);
    const float den = lr * lr + li * li, nr = ar - 1.f, ni = ai;
    const float fr = (nr * lr + ni * li) / den, fi = (ni * lr - nr * li) / den;
    float bbr[16], bbi[16];
#pragma unroll
    for (int h = 0; h < 16; ++h) { float br = p.in[I_BRE][((size_t)g * 64 + lane) * 16 + h], bi = p.in[I_BIM][((size_t)g * 64 + lane) * 16 + h];
        bbr[h] = fr * br - fi * bi; bbi[h] = fr * bi + fi * br; }
    float hr = 0.f, hi = 0.f;
    __syncthreads();
    for (int s = 0; s < NMETA + SEQ; ++s) {
        const size_t row = s < NMETA ? (size_t)(MX + s) : (size_t)b * SEQ + (s - NMETA);
        if (lane < 16) su[lane] = bf2f(Z[row * NZ0 + g * 16 + lane]);
        __syncthreads();
        float bur = 0.f, bui = 0.f;
#pragma unroll
        for (int h = 0; h < 16; ++h) { bur += su[h] * bbr[h]; bui += su[h] * bbi[h]; }
        const float nhr = ar * hr - ai * hi + bur, nhi = ar * hi + ai * hr + bui;
        hr = nhr; hi = nhi; shr[lane] = hr; shi[lane] = hi;
        __syncthreads();
        const int h = lane >> 2, q = lane & 3;
        float y = 0.f;
        for (int pp = q * 16; pp < q * 16 + 16; ++pp) y += shr[pp] * scre[h][pp] - shi[pp] * scim[h][pp];
        y += __shfl_xor(y, 1); y += __shfl_xor(y, 2);
        if (q == 0 && (s >= NMETA || b == 0)) {
            y += p.in[I_S5D][g * 16 + h] * su[h];
            YP[row * 512 + g * 16 + h] = f2bf(gelu_tanh(y));
        }
        __syncthreads();
    }
}

__global__ void __launch_bounds__(256) n_attn(P p) {
    const int r = blockIdx.x, h = threadIdx.x >> 6, lane = threadIdx.x & 63;
    const bf16* Z = (const bf16*)(p.ws + WS_Z); bf16* YM = (bf16*)(p.ws + WS_YM);
    __shared__ float sc[4][NMETA + SEQ];
    __shared__ float sq[4][64];
    int nk, b = 0;
    if (r >= MX) nk = NMETA; else { b = r >> 11; int t = r & 2047; nk = NMETA + 64 * (t / 64 + 1); }
    const float l1 = wave_sum(p.in[I_LQ1][lane] * p.in[I_LK1][lane]);
    const float l2 = wave_sum(p.in[I_LQ2][lane] * p.in[I_LK2][lane]);
    const float lam = expf(l1) - expf(l2) + LAM_INIT;
    float o[2][2];
    for (int c = 0; c < 2; ++c) {
        sq[h][lane] = bf2f(Z[(size_t)r * NZ0 + 512 + h * 128 + c * 64 + lane]);
        __syncthreads();
        float mx = -1e30f;
        for (int kk = lane; kk < nk; kk += 64) {
            const size_t kr = kk < NMETA ? (size_t)(MX + kk) : (size_t)b * SEQ + (kk - NMETA);
            const bf16* kp = Z + kr * NZ0 + 1024 + h * 128 + c * 64;
            float s = 0.f;
            for (int d = 0; d < 64; ++d) s += sq[h][d] * bf2f(kp[d]);
            sc[h][kk] = s; mx = fmaxf(mx, s);
        }
        mx = wave_max(mx);
        float l = 0.f;
        for (int kk = lane; kk < nk; kk += 64) { float e = exp2f(sc[h][kk] - mx); sc[h][kk] = e; l += e; }
        l = wave_sum(l);
        __syncthreads();
        float a0 = 0.f, a1 = 0.f;
        for (int kk = 0; kk < nk; ++kk) {
            const size_t kr = kk < NMETA ? (size_t)(MX + kk) : (size_t)b * SEQ + (kk - NMETA);
            const bf16* vp = Z + kr * NZ0 + 1536 + h * 128 + lane * 2;
            const float pw = sc[h][kk];
            a0 += pw * bf2f(vp[0]); a1 += pw * bf2f(vp[1]);
        }
        o[c][0] = a0 / l; o[c][1] = a1 / l;
        __syncthreads();
    }
    float v0 = o[0][0] - lam * o[1][0], v1 = o[0][1] - lam * o[1][1];
    float ss = wave_sum(v0 * v0 + v1 * v1);
    float rs = 1.f / sqrtf(ss / 128.f + LN_EPS);
    v0 = v0 * rs * p.in[I_SUBLN][lane * 2] * (1.f - LAM_INIT); v1 = v1 * rs * p.in[I_SUBLN][lane * 2 + 1] * (1.f - LAM_INIT);
    YM[(size_t)r * D + 512 + h * 128 + lane * 2] = f2bf(v0);
    YM[(size_t)r * D + 512 + h * 128 + lane * 2 + 1] = f2bf(v1);
}

template <int L> __global__ void __launch_bounds__(256) n_router(P p) {
    const int wave = threadIdx.x >> 6, lane = threadIdx.x & 63;
    const int r = blockIdx.x * 4 + wave; if (r >= MR) return;
    const bf16* R1 = (const bf16*)(p.ws + WS_R1); bf16* Hb = (bf16*)(p.ws + WS_HB);
    const float* g = p.in[L ? I_L1LN1G : I_L0LN1G]; const float* bb = p.in[L ? I_L1LN1B : I_L0LN1B];
    const float* wc = p.in[L ? I_M1WC : I_M0WC]; const float* bc = p.in[L ? I_M1BC : I_M0BC];
    const float* wf = p.in[L ? I_M1WF : I_M0WF]; const float* bfi = p.in[L ? I_M1BF : I_M0BF];
    float v[16]; float s = 0.f;
#pragma unroll
    for (int j = 0; j < 16; ++j) { v[j] = bf2f(R1[(size_t)r * D + j * 64 + lane]); s += v[j]; }
    const float mean = wave_sum(s) / D; float q = 0.f;
#pragma unroll
    for (int j = 0; j < 16; ++j) { v[j] -= mean; q += v[j] * v[j]; }
    const float rstd = 1.f / sqrtf(wave_sum(q) / D + LN_EPS);
#pragma unroll
    for (int j = 0; j < 16; ++j) { int c = j * 64 + lane; bf16 hb = f2bf(v[j] * rstd * g[c] + bb[c]); v[j] = bf2f(hb); Hb[(size_t)r * D + c] = hb; }
    float lc[4];
#pragma unroll
    for (int c4 = 0; c4 < 4; ++c4) { float a = 0.f;
#pragma unroll
        for (int j = 0; j < 16; ++j) a += v[j] * wc[(size_t)(j * 64 + lane) * 4 + c4];
        lc[c4] = wave_sum(a) + bc[c4]; }
    int grp = 0; float mxc = lc[0];
#pragma unroll
    for (int c4 = 1; c4 < 4; ++c4) if (lc[c4] > mxc) { mxc = lc[c4]; grp = c4; }
    float se = 0.f;
#pragma unroll
    for (int c4 = 0; c4 < 4; ++c4) se += expf(lc[c4] - mxc);
    const float pgrp = 1.f / se;
    float lf[8];
#pragma unroll
    for (int e8 = 0; e8 < 8; ++e8) { float a = 0.f;
#pragma unroll
        for (int j = 0; j < 16; ++j) a += v[j] * wf[((size_t)grp * D + j * 64 + lane) * 8 + e8];
        lf[e8] = wave_sum(a) + bfi[grp * 8 + e8]; }
    int i0 = 0; float v0 = lf[0];
#pragma unroll
    for (int e8 = 1; e8 < 8; ++e8) if (lf[e8] > v0) { v0 = lf[e8]; i0 = e8; }
    int i1 = -1; float v1 = -1e30f;
#pragma unroll
    for (int e8 = 0; e8 < 8; ++e8) if (e8 != i0 && lf[e8] > v1) { v1 = lf[e8]; i1 = e8; }
    const float e1 = expf(v1 - v0); const float g0 = pgrp / (1.f + e1), g1 = pgrp * e1 / (1.f + e1);
    if (lane == 0) {
        int* cnt = (int*)(p.ws + WS_CTL) + (L ? CW_CNT1 : CW_CNT0);
        int* list = (int*)(p.ws + WS_ROUTE); float* gate = (float*)(p.ws + WS_GATE);
        const int ea = grp * 8 + i0, eb = grp * 8 + i1;
        int pa = atomicAdd(&cnt[ea], 1); list[(size_t)ea * LIST_CAP + pa] = r * 2; gate[r * 2] = g0;
        int pb = atomicAdd(&cnt[eb], 1); list[(size_t)eb * LIST_CAP + pb] = r * 2 + 1; gate[r * 2 + 1] = g1;
    }
}
template <int L> __global__ void n_ebase(P p) {
    if (threadIdx.x == 0) { const int* cnt = (const int*)(p.ws + WS_CTL) + (L ? CW_CNT1 : CW_CNT0); int* ebase = (int*)(p.ws + WS_EBASE);
        int acc = 0; for (int e = 0; e < NE; ++e) { ebase[e] = acc; acc += (cnt[e] + 255) / 256 * 256; } }
}
template <int L> __global__ void __launch_bounds__(256) n_combine(P p) {
    const int wave = threadIdx.x >> 6, lane = threadIdx.x & 63;
    const int r = blockIdx.x * 4 + wave; if (r >= MR) return;
    bf16* Hb = (bf16*)(p.ws + WS_HB); const bf16* Y2 = (const bf16*)(p.ws + WS_Z);
    const float* g = p.in[L ? I_L1LN2G : I_L0LN2G]; const float* bb = p.in[L ? I_L1LN2B : I_L0LN2B];
    float v[16]; float s = 0.f;
#pragma unroll
    for (int j = 0; j < 16; ++j) { int c = j * 64 + lane; v[j] = ALPHA * bf2f(Hb[(size_t)r * D + c]) + bf2f(Y2[(size_t)(2 * r) * D + c]) + bf2f(Y2[(size_t)(2 * r + 1) * D + c]); s += v[j]; }
    const float mean = wave_sum(s) / D; float q = 0.f;
#pragma unroll
    for (int j = 0; j < 16; ++j) { v[j] -= mean; q += v[j] * v[j]; }
    const float rstd = 1.f / sqrtf(wave_sum(q) / D + LN_EPS);
#pragma unroll
    for (int j = 0; j < 16; ++j) { int c = j * 64 + lane; float o = v[j] * rstd * g[c] + bb[c];
        if (L == 0) Hb[(size_t)r * D + c] = f2bf(o); else if (r < MX) p.out[(size_t)r * D + c] = o; }
}
__global__ void __launch_bounds__(128) n_lru(P p) {
    const int b = blockIdx.x / 10, n = blockIdx.x % 10, c = threadIdx.x, ch = n * 128 + c;
    const bf16* Z = (const bf16*)(p.ws + WS_Z); bf16* Y1 = (bf16*)(p.ws + WS_YM);
    __shared__ float xc[128];
    const float cw0 = p.in[I_CONVW][ch], cw1 = p.in[I_CONVW][DRNN + ch], cw2 = p.in[I_CONVW][2 * DRNN + ch], cw3 = p.in[I_CONVW][3 * DRNN + ch], cb = p.in[I_CONVB][ch];
    const float* wa = p.in[I_WA] + (size_t)n * 128 * 128; const float* wx = p.in[I_WX] + (size_t)n * 128 * 128;
    const float ba = p.in[I_BA][ch], bx = p.in[I_BX][ch];
    const float lam = p.in[I_LAM][ch]; const float sp = log1pf(expf(-lam));
    float r0 = 0.f, r1 = 0.f, r2 = 0.f, hstate = 0.f;
    for (int s = 0; s < NMETA + SEQ; ++s) {
        const size_t row = s < NMETA ? (size_t)(MX + s) : (size_t)b * SEQ + (s - NMETA);
        const float r3 = bf2f(Z[row * NZ1 + DRNN + ch]);
        const float x = r0 * cw0 + r1 * cw1 + r2 * cw2 + r3 * cw3 + cb;
        r0 = r1; r1 = r2; r2 = r3;
        xc[c] = x;
        __syncthreads();
        float aa = 0.f, ax = 0.f;
        for (int d = 0; d < 128; ++d) { const float xv = xc[d]; aa += xv * wa[d * 128 + c]; ax += xv * wx[d * 128 + c]; }
        const float rg = sigmoidf_(aa + ba), ig = sigmoidf_(ax + bx);
        const float log_a = -8.f * rg * sp; const float a = expf(log_a);
        const float bt = sqrtf(-expm1f(2.f * log_a)) * (ig * x);
        hstate = a * hstate + bt;
        if (s >= NMETA || b == 0) Y1[row * DRNN + ch] = f2bf(bf2f(Z[row * NZ1 + ch]) * hstate);
        __syncthreads();
    }
}

namespace pg8 {
#define PG8_LAS __attribute__((address_space(3)))
typedef unsigned short bf16_t;
typedef short bf16x8 __attribute__((ext_vector_type(8)));
typedef float f32x4 __attribute__((ext_vector_type(4)));
typedef float f32x2 __attribute__((ext_vector_type(2)));
typedef unsigned u32x4 __attribute__((ext_vector_type(4)));
typedef unsigned u32x2 __attribute__((ext_vector_type(2)));
constexpr int BM = 256, BK = 64, HALF = 128, HTB = HALF * BK * 2  , STAGE_BYTES = 8 * HTB, NXCD = 8, WGM = 8;

__host__ __device__ __forceinline__ int lds_byte(int r, int c) { const int st = (r >> 4) * 2 + (c >> 5), rr = r & 15, cc = c & 31, ob = rr * 64 + cc * 2; return st * 1024 + (ob ^ (((ob >> 9) & 1) << 5)); }
__host__ __device__ __forceinline__ void stage_rc(int b, int& R, int& C) { const int st = b / 1024, sb = b % 1024, swz = sb ^ (((sb >> 9) & 1) << 5); R = (st >> 1) * 16 + swz / 64; C = (st & 1) * 32 + (swz % 64) / 2; }
__host__ __device__ __forceinline__ int perm32(int rho) { const int n = rho >> 4, i = rho & 15; return 8 * (i >> 2) + 4 * n + (i & 3); }

struct Unit { const char* a; const char* b; int pm, pn, ex, nrow; };

struct DenseOrder {
    static constexpr bool GATHER = false;
    const char* A; const char* Bt; int K; int nM, nN, nwg, G, c;
    __device__ void init(const void* A_, const void* Bt_, int M, int N, int K_, int G_, int c_) { A = (const char*)A_; Bt = (const char*)Bt_; K = K_; nM = M / BM; nN = N / BM; nwg = nM * nN; G = G_; c = c_; }
    __device__ bool next(int i, Unit& u) const {
        const long L = (long)i * G + c; if (L >= nwg) return false;
        int wgid = (int)L; { const int q = nwg / NXCD, r = nwg % NXCD, xcd = wgid % NXCD, off = wgid / NXCD; wgid = (xcd < r ? xcd * (q + 1) : r * (q + 1) + (xcd - r) * q) + off; }
        const int nig = WGM * nN, gid = wgid / nig, fm = gid * WGM, gsz = (nM - fm) < WGM ? (nM - fm) : WGM;
        u.pm = fm + ((wgid % nig) % gsz); u.pn = (wgid % nig) / gsz; u.ex = 0; u.nrow = BM;
        u.a = A + (size_t)u.pm * BM * K * 2; u.b = Bt + (size_t)u.pn * BM * K * 2; return true;
    }
    __device__ __forceinline__ void voffs(const Unit&, int, unsigned (&)[2], unsigned (&)[2]) const {}
};

__device__ __forceinline__ unsigned cvt_pk_bf16(float lo, float hi) { unsigned r; asm volatile("v_cvt_pk_bf16_f32 %0, %1, %2" : "=v"(r) : "v"(lo), "v"(hi)); return r; }

template <class Epi, class Sched, bool ALIGN_EPI>
__device__ __forceinline__ void gemm_phase(PG8_LAS unsigned char* lds, const int K, const Sched& S, const Epi& E) {
    constexpr bool GATHER = Sched::GATHER;
    int tid_ = threadIdx.x; asm volatile("" : "+v"(tid_));
    const int tid = tid_, wid = __builtin_amdgcn_readfirstlane(tid >> 6), lane = tid & 63, wr = wid >> 2, wc = wid & 3, fr = lane & 15, fq = lane >> 4;
    const int nt = K / BK;
    unsigned voffA[2], voffA1[2], voffB[2];
#pragma unroll
    for (int i = 0; i < 2; ++i) { int R, C; stage_rc(tid * 16 + i * 8192, R, C); const int Rb = Epi::PERM ? ((R & ~31) + perm32(R & 31)) : R;
        voffA[i] = (unsigned)(R * K + C) * 2u; voffA1[i] = voffA[i]; voffB[i] = (unsigned)(Rb * K + C) * 2u; }
    const size_t kstep = (size_t)(BK * 2);
    const size_t hstep = (size_t)HALF * K * 2;
    const size_t hstepA = GATHER ? 0 : hstep;
    const unsigned ldsw = (unsigned)wid * 1024u;
    const int aoff = lds_byte(wr * 64 + fr, fq * 8), boff = lds_byte(wc * 32 + fr, fq * 8);
#define PG8_SA(b, h) (((b) * 2 + (h)) * HTB)
#define PG8_SB(b, h) ((4 + (b) * 2 + (h)) * HTB)
#define PG8_STAGE(bufoff, gbase, voff) do { _Pragma("unroll") for (int _i = 0; _i < 2; ++_i) \
        __builtin_amdgcn_global_load_lds((const unsigned*)((const char*)(gbase) + (voff)[_i]), (PG8_LAS unsigned*)(lds + (bufoff) + ldsw + _i * 8192), 16, 0, 0); } while (0)
#define PG8_STAGE_A0(b, gbase) PG8_STAGE(PG8_SA(b, 0), gbase, voffA)
#define PG8_STAGE_A1(b, gbase) PG8_STAGE(PG8_SA(b, 1), (gbase) + hstepA, voffA1)
#define PG8_LDA(dst, b, h) do { _Pragma("unroll") for (int m = 0; m < 4; ++m) _Pragma("unroll") for (int k = 0; k < 2; ++k) dst[m][k] = *(const PG8_LAS bf16x8*)(lds + PG8_SA(b, h) + aoff + m * 2048 + k * 1024); } while (0)
#define PG8_LDB(dst, b, h) do { _Pragma("unroll") for (int n = 0; n < 2; ++n) _Pragma("unroll") for (int k = 0; k < 2; ++k) dst[n][k] = *(const PG8_LAS bf16x8*)(lds + PG8_SB(b, h) + boff + n * 2048 + k * 1024); } while (0)
#define PG8_MMA(ai, bj, At, Bt) do { __builtin_amdgcn_s_setprio(1); _Pragma("unroll") for (int m = 0; m < 4; ++m) _Pragma("unroll") for (int n = 0; n < 2; ++n) _Pragma("unroll") for (int k = 0; k < 2; ++k) \
        acc[ai][bj][m][n] = __builtin_amdgcn_mfma_f32_16x16x32_bf16(Bt[n][k], At[m][k], acc[ai][bj][m][n], 0, 0, 0); __builtin_amdgcn_s_setprio(0); } while (0)
#define PG8_WAIT_V(n) asm volatile("s_waitcnt vmcnt(" #n ")" ::: "memory")
#define PG8_WAIT_L(n) asm volatile("s_waitcnt lgkmcnt(" #n ")" ::: "memory")
#define PG8_BAR __builtin_amdgcn_s_barrier()
#define PG8_SCHED __builtin_amdgcn_sched_barrier(0)
    Unit cur, nxt; int ui = 0;
    if (!S.next(0, cur)) return;
    if (GATHER) S.voffs(cur, tid, voffA, voffA1);
    f32x4 acc[2][2][4][2];
#pragma unroll
    for (int a = 0; a < 2; ++a)
#pragma unroll
        for (int b = 0; b < 2; ++b)
#pragma unroll
            for (int m = 0; m < 4; ++m)
#pragma unroll
                for (int n = 0; n < 2; ++n) acc[a][b][m][n] = (f32x4){0.f, 0.f, 0.f, 0.f};
    bf16x8 At[4][2], B0[2][2], B1[2][2];
    const char* cA = cur.a; const char* cB = cur.b;
    PG8_STAGE(PG8_SB(0, 0), cB, voffB); PG8_STAGE(PG8_SB(0, 1), cB + hstep, voffB); PG8_STAGE_A0(0, cA); PG8_STAGE_A1(0, cA);
    if (wr == 1) PG8_BAR;
    PG8_WAIT_V(2); PG8_BAR;
    PG8_STAGE(PG8_SB(1, 0), cB + kstep, voffB); PG8_STAGE_A0(1, cA + kstep); PG8_STAGE(PG8_SB(1, 1), cB + hstep + kstep, voffB);
    PG8_WAIT_V(6); PG8_BAR;
    for (;;) {
        const bool has_next = S.next(ui + 1, nxt);
        const char* nA = has_next ? nxt.a : cA; const char* nB = has_next ? nxt.b : cB;
        for (int t = 0; t < nt; t += 2) {
            const bool last = (t == nt - 2);
            const char* a1 = cA + (size_t)(t + 1) * kstep;
            const char* a2 = last ? nA : cA + (size_t)(t + 2) * kstep; const char* b2 = last ? nB : cB + (size_t)(t + 2) * kstep;
            const char* a3 = a2 + kstep; const char* b3 = b2 + kstep;
            PG8_LDB(B0, 0, 0); PG8_LDB(B1, 0, 1); PG8_SCHED; PG8_LDA(At, 0, 0); PG8_STAGE_A1(1, a1);
            if (GATHER) { if (last && has_next) S.voffs(nxt, tid, voffA, voffA1); }
            PG8_WAIT_V(8); PG8_WAIT_L(0); PG8_BAR; PG8_MMA(0, 0, At, B0); PG8_MMA(0, 1, At, B1); PG8_BAR; PG8_SCHED;
            PG8_LDA(At, 0, 1); PG8_STAGE(PG8_SB(0, 0), b2, voffB); PG8_STAGE(PG8_SB(0, 1), b2 + hstep, voffB); PG8_STAGE_A0(0, a2);
            PG8_WAIT_V(8); PG8_WAIT_L(0); PG8_BAR; PG8_MMA(1, 0, At, B0); PG8_MMA(1, 1, At, B1); PG8_BAR; PG8_SCHED;
            PG8_LDB(B0, 1, 0); PG8_LDB(B1, 1, 1); PG8_SCHED; PG8_LDA(At, 1, 0); PG8_STAGE_A1(0, a2);
            PG8_WAIT_V(8); PG8_WAIT_L(0); PG8_BAR; PG8_MMA(0, 0, At, B0); PG8_MMA(0, 1, At, B1); PG8_BAR; PG8_SCHED;
            PG8_LDA(At, 1, 1); PG8_STAGE(PG8_SB(1, 0), b3, voffB); PG8_STAGE(PG8_SB(1, 1), b3 + hstep, voffB); PG8_STAGE_A0(1, a3);
            PG8_WAIT_V(8); PG8_WAIT_L(0); PG8_BAR; PG8_MMA(1, 0, At, B0); PG8_MMA(1, 1, At, B1); PG8_BAR; PG8_SCHED;
        }
        if constexpr (ALIGN_EPI) { if (wr == 0) PG8_BAR; }
        E(acc, cur, wr, wc, fr, fq);
        if (!has_next) break;
#pragma unroll
        for (int a = 0; a < 2; ++a)
#pragma unroll
            for (int b = 0; b < 2; ++b)
#pragma unroll
                for (int m = 0; m < 4; ++m)
#pragma unroll
                    for (int n = 0; n < 2; ++n) acc[a][b][m][n] = (f32x4){0.f, 0.f, 0.f, 0.f};
        cur = nxt; cA = nA; cB = nB; ++ui;
        if constexpr (ALIGN_EPI) { if (wr == 1) PG8_BAR; }
    }
    PG8_WAIT_V(0);
    if constexpr (!ALIGN_EPI) { if (wr == 0) PG8_BAR; }
    PG8_BAR;
#undef PG8_SA
#undef PG8_SB
#undef PG8_STAGE
#undef PG8_STAGE_A0
#undef PG8_STAGE_A1
#undef PG8_LDA
#undef PG8_LDB
#undef PG8_MMA
#undef PG8_WAIT_V
#undef PG8_WAIT_L
#undef PG8_BAR
#undef PG8_SCHED
}
}
#define GAS __attribute__((address_space(1)))
#define LAS __attribute__((address_space(3)))
typedef unsigned v4u __attribute__((ext_vector_type(4)));
typedef float f32x4 __attribute__((ext_vector_type(4)));
typedef short bf16x8 __attribute__((ext_vector_type(8)));
#define LDS_WAIT() asm volatile("s_waitcnt lgkmcnt(0)" ::: "memory")
#define VM_WAIT() asm volatile("s_waitcnt vmcnt(0)" ::: "memory")
__device__ __forceinline__ unsigned pk2(float lo, float hi) { return (unsigned)f2bf(lo) | ((unsigned)f2bf(hi) << 16); }

#define XB_TMO      128
#define XB_XCNT(j)  (256  + 64 * (j))
#define XB_XSUB(j)  (1280 + 64 * (j))
#define XB_XGEN(j)  (2304 + 64 * (j))
#define XB_TOP      3328
#define XB_TOPGEN   3392
#define XCD_BAR_WORDS 3456
#define XB_SPIN_CAP (1u << 18)
__device__ __forceinline__ unsigned xb_ld(unsigned* p)              { return __hip_atomic_load(p, __ATOMIC_RELAXED, __HIP_MEMORY_SCOPE_AGENT); }
__device__ __forceinline__ unsigned xb_add(unsigned* p, unsigned v) { return __hip_atomic_fetch_add(p, v, __ATOMIC_RELAXED, __HIP_MEMORY_SCOPE_AGENT); }
__device__ __forceinline__ unsigned xb_xcc_id() { return (unsigned)__builtin_amdgcn_s_getreg((3 << 11) | 20) & 0xFu; }
#define XB_SPIN(cond, bar) do { unsigned _sp = 0; while (cond) { __builtin_amdgcn_s_sleep(1); \
    if ((++_sp & 255u) == 0u) { if (xb_ld(&(bar)[XB_TMO])) break; if (_sp > XB_SPIN_CAP) { atomicAdd(&(bar)[XB_TMO], 1u); break; } } } } while (0)
struct XcdBarrier { unsigned* bar; unsigned x; volatile LAS unsigned* st; };
__device__ __forceinline__ XcdBarrier xcd_barrier_post(unsigned* bar, volatile LAS unsigned* st) {
    XcdBarrier b; b.bar = bar; b.x = xb_xcc_id(); b.st = st;
    if (threadIdx.x == 0) (void)xb_add(&bar[XB_XCNT(b.x)], 1u);
    return b;
}
__device__ __forceinline__ void xcd_barrier_complete(unsigned* bar, unsigned x, unsigned& nloc, unsigned& nx) {
    const unsigned G = gridDim.x * gridDim.y * gridDim.z;
    unsigned sum, cnt, mine, sp = 0u;
    for (;;) {
        sum = 0u; cnt = 0u; mine = 0u;
#pragma unroll
        for (unsigned j = 0; j < 16; ++j) { const unsigned c = xb_ld(&bar[XB_XCNT(j)]); sum += c; cnt += (c > 0u) ? 1u : 0u; mine = (j == x) ? c : mine; }
        if (sum == G) break;
        __builtin_amdgcn_s_sleep(1);
        if ((++sp & 255u) == 0u) { if (xb_ld(&bar[XB_TMO])) break; if (sp > XB_SPIN_CAP) { atomicAdd(&bar[XB_TMO], 1u); break; } }
    }
    nloc = mine > 0u ? mine : 1u; nx = cnt > 0u ? cnt : 1u;
}
__device__ __forceinline__ void xcd_barrier(const XcdBarrier& b) {
    asm volatile("s_waitcnt vmcnt(0)" ::: "memory");
    __syncthreads();
    if (threadIdx.x == 0) {
        unsigned* bar = b.bar;
        __builtin_amdgcn_s_waitcnt(0);
        unsigned nloc = b.st[0], nx = b.st[1];
        if (nloc == 0u) { xcd_barrier_complete(bar, b.x, nloc, nx); b.st[0] = nloc; b.st[1] = nx; }
        const unsigned old = xb_add(&bar[XB_XSUB(b.x)], 1u);
        const unsigned gen = old / nloc;
        if (old + 1u == (gen + 1u) * nloc) {
            __builtin_amdgcn_fence(__ATOMIC_RELEASE, "agent");
            asm volatile("s_waitcnt vmcnt(0)" ::: "memory");
            const unsigned og = xb_add(&bar[XB_TOP], 1u);
            const unsigned tg = og / nx;
            if (og + 1u == (tg + 1u) * nx) xb_add(&bar[XB_TOPGEN], 1u);
            else XB_SPIN(xb_ld(&bar[XB_TOPGEN]) == tg, bar);
            __builtin_amdgcn_fence(__ATOMIC_ACQUIRE, "agent");
            xb_add(&bar[XB_XGEN(b.x)], 1u);
            asm volatile("s_waitcnt vmcnt(0)" ::: "memory");
        } else {
            XB_SPIN(xb_ld(&bar[XB_XGEN(b.x)]) == gen, bar);
            __builtin_amdgcn_fence(__ATOMIC_ACQUIRE, "agent");
            asm volatile("s_waitcnt vmcnt(0)" ::: "memory");
        }
    }
    __syncthreads();
}

constexpr int RING_BYTES = 131072;
constexpr int MISC_OFF = RING_BYTES + 320;
constexpr int LDS_BYTES = 147456;
constexpr int NWAVES = 8;
constexpr int CW_BAR = 4096;

constexpr size_t WB_WIN0 = WS_WB;
constexpr size_t WB_WGLU = WB_WIN0 + 4 * MiB;
constexpr size_t WB_WOUT0 = WB_WGLU + MiB / 2;
constexpr size_t WB_WIN1 = WB_WOUT0 + 2 * MiB;
constexpr size_t WB_WOUT1 = WB_WIN1 + 5 * MiB;
constexpr size_t WB_WAX = WB_WOUT1 + 5 * MiB / 2;
constexpr size_t WB_END = WB_WAX + MiB;
constexpr size_t MOE_WGU = 0, MOE_WD = 64 * MiB;

struct Frame {
    LAS unsigned char* lds;
    int tid, lane, wave, G, vcu;
};

__device__ __forceinline__ void transpose_item(const float* W, int N, int k0, int n0, bf16* WTrow0, int ldt, LAS float* scr, int lane) {
#pragma unroll 8
    for (int i = 0; i < 32; ++i) { const int kk = 2 * i + (lane >> 5); scr[kk * 33 + (lane & 31)] = W[(size_t)(k0 + kk) * N + n0 + (lane & 31)]; }
    LDS_WAIT(); asm volatile("" ::: "memory");
    const int c = lane & 7;
#pragma unroll
    for (int j = 0; j < 4; ++j) { const int n = (lane >> 3) + 8 * j; const LAS float* s = scr + (8 * c) * 33 + n;
        v4u o; o.x = pk2(s[0 * 33], s[1 * 33]); o.y = pk2(s[2 * 33], s[3 * 33]); o.z = pk2(s[4 * 33], s[5 * 33]); o.w = pk2(s[6 * 33], s[7 * 33]);
        *(GAS v4u*)(WTrow0 + (size_t)n * ldt + k0 + 8 * c) = o; }
    LDS_WAIT(); asm volatile("" ::: "memory");
}
constexpr int CI_WIN0 = 1024, CI_WGLU = 128, CI_WOUT0 = 512, CI_WIN1 = 1280, CI_WOUT1 = 640, CI_WAX = 160, CI_MOE = 24576;
constexpr int CI_SMALL = CI_WIN0 + CI_WGLU + CI_WOUT0 + CI_WIN1 + CI_WOUT1 + CI_WAX;
constexpr int CI_TOTAL = CI_SMALL + 2 * CI_MOE;
struct ArgsF { P p; int ph_lo, ph_hi, li, pad; };
typedef __attribute__((address_space(4))) const ArgsF CArgsF;
__device__ __forceinline__ void cvt_item(CArgsF* q, int it, LAS float* scr, int lane) {
    const float* W; int N, K, r = it; bf16* WT;
    if (r < CI_WIN0) { W = q->p.in[I_L0WIN]; K = D; N = NZ0; WT = (bf16*)(q->p.ws + WB_WIN0); }
    else if ((r -= CI_WIN0) < CI_WGLU) { W = q->p.in[I_WGLU]; K = 512; N = 512; WT = (bf16*)(q->p.ws + WB_WGLU); }
    else if ((r -= CI_WGLU) < CI_WOUT0) { W = q->p.in[I_L0WOUT]; K = D; N = D; WT = (bf16*)(q->p.ws + WB_WOUT0); }
    else if ((r -= CI_WOUT0) < CI_WIN1) { W = q->p.in[I_L1WIN]; K = D; N = NZ1; WT = (bf16*)(q->p.ws + WB_WIN1); }
    else if ((r -= CI_WIN1) < CI_WOUT1) { W = q->p.in[I_L1WOUT]; K = DRNN; N = D; WT = (bf16*)(q->p.ws + WB_WOUT1); }
    else if ((r -= CI_WOUT1) < CI_WAX) { const int blk = r >> 4, gsel = (r >> 3) & 1; r &= 7;
        W = (gsel ? q->p.in[I_WX] : q->p.in[I_WA]) + (size_t)blk * 128 * 128; K = 128; N = 128; WT = (bf16*)(q->p.ws + WB_WAX) + (size_t)(blk * 2 + gsel) * 128 * 128; }
    else { r -= CI_WAX; const int L = r >= CI_MOE; if (L) r -= CI_MOE; const int e = r / 768; r -= e * 768; const int which = r >> 8; r &= 255;
        unsigned char* mb = q->p.ws + (L ? WS_MOE1 : WS_MOE0);
        if (which < 2) {
            W = (L ? (which ? q->p.in[I_M1WU] : q->p.in[I_M1WG]) : (which ? q->p.in[I_M0WU] : q->p.in[I_M0WG])) + (size_t)e * D * 512; K = D; N = 512;
            const int kb = r / 16, nb = r % 16, n0 = nb * 32;
            bf16* dst = (bf16*)(mb + MOE_WGU) + ((size_t)e * 1024 + 256 * (n0 >> 7) + (n0 & 127) + 128 * which) * 1024;
            transpose_item(W, N, kb * 64, n0, dst, 1024, scr, lane); return; }
        W = (L ? q->p.in[I_M1WD] : q->p.in[I_M0WD]) + (size_t)e * 512 * D; K = 512; N = D; WT = (bf16*)(mb + MOE_WD) + (size_t)e * 1024 * 512; }
    const int nblk = N / 32, kb = r / nblk, nb = r % nblk;
    transpose_item(W, N, kb * 64, nb * 32, WT + (size_t)(nb * 32) * K, K, scr, lane);
}
template <class E>
__device__ __forceinline__ void meta_gemm(const Frame& F, const P& p, const bf16* A16, int lda, const bf16* Bt, int N, int K, const E& e) {
    const int gw = F.vcu * NWAVES + F.wave, NGW = F.G * NWAVES;
    const int lane = F.lane, r = lane & 15, q = lane >> 4;
    for (int tile = gw; tile < N / 16; tile += NGW) {
        f32x4 acc = {0.f, 0.f, 0.f, 0.f};
        const bf16* ap = A16 + (size_t)r * lda + q * 8; const bf16* bp = Bt + (size_t)(tile * 16 + r) * K + q * 8;
        for (int k = 0; k < K; k += 32) {
            const bf16x8 a = *(const bf16x8*)(ap + k); const bf16x8 b = *(const bf16x8*)(bp + k);
            acc = __builtin_amdgcn_mfma_f32_16x16x32_bf16(a, b, acc, 0, 0, 0);
        }
#pragma unroll
        for (int i = 0; i < 4; ++i) e.store(p, 0, MX + q * 4 + i, tile * 16 + r, acc[i], 0.f);
    }
}

struct FEpiZ0 {
    static constexpr bool PERM = true;
    bf16* Z;
    __device__ __forceinline__ void operator()(const pg8::f32x4 (&acc)[2][2][4][2], const pg8::Unit& u, int wr, int wc, int fr, int fq) const {
        const int row0 = u.pm * 256 + wr * 64 + fr, col0 = u.pn * 256 + wc * 32 + 8 * fq;
        const float sc = (u.pn == 2 || u.pn == 3) ? QSCALE : 1.f;
#pragma unroll
        for (int ai = 0; ai < 2; ++ai)
#pragma unroll
            for (int m = 0; m < 4; ++m) { bf16* rowp = Z + (size_t)(row0 + ai * 128 + m * 16) * NZ0 + col0;
#pragma unroll
                for (int bj = 0; bj < 2; ++bj) { const pg8::f32x4 v0 = acc[ai][bj][m][0] * sc, v1 = acc[ai][bj][m][1] * sc;
                    pg8::u32x4 w; w.x = pg8::cvt_pk_bf16(v0[0], v0[1]); w.y = pg8::cvt_pk_bf16(v0[2], v0[3]); w.z = pg8::cvt_pk_bf16(v1[0], v1[1]); w.w = pg8::cvt_pk_bf16(v1[2], v1[3]);
                    *(pg8::u32x4*)(rowp + bj * 128) = w; } }
    }
};


__device__ __forceinline__ float fast_sigmoid(float v) { return __builtin_amdgcn_rcpf(1.f + __builtin_amdgcn_exp2f(-1.4426950408889634f * v)); }
__device__ __forceinline__ float fast_gelu(float x) { const float u = x + 0.044715f * x * x * x; return x * __builtin_amdgcn_rcpf(1.f + __builtin_amdgcn_exp2f(-2.302208198f * u)); }
__device__ __forceinline__ pg8::u32x4 pack8(const pg8::f32x4& v0, const pg8::f32x4& v1) {
    pg8::u32x4 w; w.x = pg8::cvt_pk_bf16(v0[0], v0[1]); w.y = pg8::cvt_pk_bf16(v0[2], v0[3]); w.z = pg8::cvt_pk_bf16(v1[0], v1[1]); w.w = pg8::cvt_pk_bf16(v1[2], v1[3]); return w; }
__device__ __forceinline__ void unpack8(const pg8::u32x4& w, pg8::f32x4& v0, pg8::f32x4& v1) {
    v0[0] = __uint_as_float(w.x << 16); v0[1] = __uint_as_float(w.x & 0xffff0000u); v0[2] = __uint_as_float(w.y << 16); v0[3] = __uint_as_float(w.y & 0xffff0000u);
    v1[0] = __uint_as_float(w.z << 16); v1[1] = __uint_as_float(w.z & 0xffff0000u); v1[2] = __uint_as_float(w.w << 16); v1[3] = __uint_as_float(w.w & 0xffff0000u); }

struct FEpiGLU {
    static constexpr bool PERM = true;
    const bf16* YP; bf16* YM; const float* bias;
    __device__ __forceinline__ void operator()(const pg8::f32x4 (&acc)[2][2][4][2], const pg8::Unit& u, int wr, int wc, int fr, int fq) const {
        const int row0 = u.pm * 256 + wr * 64 + fr, col0 = u.pn * 256 + wc * 32 + 8 * fq;
#pragma unroll
        for (int bj = 0; bj < 2; ++bj) { const pg8::f32x4 b0 = *(const pg8::f32x4*)(bias + col0 + bj * 128), b1 = *(const pg8::f32x4*)(bias + col0 + bj * 128 + 4);
#pragma unroll
            for (int ai = 0; ai < 2; ++ai)
#pragma unroll
                for (int m = 0; m < 4; ++m) { const size_t row = (size_t)(row0 + ai * 128 + m * 16);
                    pg8::f32x4 y0, y1; unpack8(*(const pg8::u32x4*)(YP + row * 512 + col0 + bj * 128), y0, y1);
                    pg8::f32x4 v0 = acc[ai][bj][m][0] + b0, v1 = acc[ai][bj][m][1] + b1;
#pragma unroll
                    for (int j = 0; j < 4; ++j) { v0[j] = y0[j] * fast_sigmoid(v0[j]); v1[j] = y1[j] * fast_sigmoid(v1[j]); }
                    *(pg8::u32x4*)(YM + row * D + col0 + bj * 128) = pack8(v0, v1); asm volatile("" ::: "memory"); } }
    }
};
struct FEpiOut0 {
    static constexpr bool PERM = true;
    const float* X; bf16* R1;
    __device__ __forceinline__ void operator()(const pg8::f32x4 (&acc)[2][2][4][2], const pg8::Unit& u, int wr, int wc, int fr, int fq) const {
        const int row0 = u.pm * 256 + wr * 64 + fr, col0 = u.pn * 256 + wc * 32 + 8 * fq;
#pragma unroll
        for (int ai = 0; ai < 2; ++ai)
#pragma unroll
            for (int m = 0; m < 4; ++m) { const size_t off = (size_t)(row0 + ai * 128 + m * 16) * D + col0;
#pragma unroll
                for (int bj = 0; bj < 2; ++bj) { const pg8::f32x4 x0 = *(const pg8::f32x4*)(X + off + bj * 128), x1 = *(const pg8::f32x4*)(X + off + bj * 128 + 4);
                    *(pg8::u32x4*)(R1 + off + bj * 128) = pack8(x0 * ALPHA + acc[ai][bj][m][0], x1 * ALPHA + acc[ai][bj][m][1]); }
                asm volatile("" ::: "memory"); }
    }
};
struct FEpiZ1 {
    static constexpr bool PERM = true;
    bf16* Z;
    __device__ __forceinline__ void operator()(const pg8::f32x4 (&acc)[2][2][4][2], const pg8::Unit& u, int wr, int wc, int fr, int fq) const {
        const int row0 = u.pm * 256 + wr * 64 + fr, col0 = u.pn * 256 + wc * 32 + 8 * fq; const bool g = u.pn < 5;
#pragma unroll
        for (int ai = 0; ai < 2; ++ai)
#pragma unroll
            for (int m = 0; m < 4; ++m) { bf16* rowp = Z + (size_t)(row0 + ai * 128 + m * 16) * NZ1 + col0;
#pragma unroll
                for (int bj = 0; bj < 2; ++bj) { pg8::f32x4 v0 = acc[ai][bj][m][0], v1 = acc[ai][bj][m][1];
                    if (g) {
#pragma unroll
                        for (int j = 0; j < 4; ++j) { v0[j] = fast_gelu(v0[j]); v1[j] = fast_gelu(v1[j]); } }
                    *(pg8::u32x4*)(rowp + bj * 128) = pack8(v0, v1); }
                asm volatile("" ::: "memory"); }
    }
};
struct FEpiOut1 {
    static constexpr bool PERM = true;
    const bf16* Hb; bf16* R1;
    __device__ __forceinline__ void operator()(const pg8::f32x4 (&acc)[2][2][4][2], const pg8::Unit& u, int wr, int wc, int fr, int fq) const {
        const int row0 = u.pm * 256 + wr * 64 + fr, col0 = u.pn * 256 + wc * 32 + 8 * fq;
#pragma unroll
        for (int ai = 0; ai < 2; ++ai)
#pragma unroll
            for (int m = 0; m < 4; ++m) { const size_t off = (size_t)(row0 + ai * 128 + m * 16) * D + col0;
#pragma unroll
                for (int bj = 0; bj < 2; ++bj) { pg8::f32x4 h0, h1; unpack8(*(const pg8::u32x4*)(Hb + off + bj * 128), h0, h1);
                    *(pg8::u32x4*)(R1 + off + bj * 128) = pack8(h0 * ALPHA + acc[ai][bj][m][0], h1 * ALPHA + acc[ai][bj][m][1]); }
                asm volatile("" ::: "memory"); }
    }
};

template <bool GATHER_, int NTN, int KK, int BROWS>
struct MoeOrder {
    static constexpr bool GATHER = GATHER_;
    const char* A; const char* Bt; const int* list; const int* cnt; const volatile LAS int* tp; int G, c, total;
    __device__ bool next(int i, pg8::Unit& u) const {
        const long L = (long)i * G + c; if (L >= total) return false;
        const int gt = (int)(L / NTN), pn = (int)(L % NTN);
        int e = 0;
#pragma unroll 1
        for (int k = 16; k >= 1; k >>= 1) if (__builtin_amdgcn_readfirstlane(tp[e + k]) <= gt) e += k;
        const int mt = gt - __builtin_amdgcn_readfirstlane(tp[e]);
        u.pm = gt; u.pn = pn; u.ex = e | (mt << 8); { const int left = cnt[e] - mt * 256; u.nrow = left < 256 ? left : 256; }
        u.a = GATHER ? A : A + (size_t)gt * 256 * KK * 2; u.b = Bt + ((size_t)e * BROWS + (size_t)pn * 256) * KK * 2; return true;
    }
    __device__ __forceinline__ void voffs(const pg8::Unit& u, int tid, unsigned (&v0)[2], unsigned (&v1)[2]) const {
        const int e = u.ex & 255, mt = u.ex >> 8; const int* lp = list + (size_t)e * LIST_CAP + mt * 256;
#pragma unroll
        for (int i = 0; i < 2; ++i) { int R, C; pg8::stage_rc(tid * 16 + i * 8192, R, C);
            const int t0 = R < u.nrow ? (lp[R] >> 1) : 0, t1 = (R + 128) < u.nrow ? (lp[R + 128] >> 1) : 0;
            v0[i] = (unsigned)(t0 * KK + C) * 2u; v1[i] = (unsigned)(t1 * KK + C) * 2u; }
    }
};
struct FEpiMoe1 {
    static constexpr bool PERM = true;
    bf16* HID;
    __device__ __forceinline__ void operator()(const pg8::f32x4 (&acc)[2][2][4][2], const pg8::Unit& u, int wr, int wc, int fr, int fq) const {
        const int row0 = u.pm * 256 + wr * 64 + fr, col0 = u.pn * 128 + wc * 32 + 8 * fq;
#pragma unroll
        for (int ai = 0; ai < 2; ++ai)
#pragma unroll
            for (int m = 0; m < 4; ++m) { pg8::f32x4 v0, v1;
#pragma unroll
                for (int j = 0; j < 4; ++j) { const float g0 = acc[ai][0][m][0][j], g1 = acc[ai][0][m][1][j];
                    v0[j] = g0 * fast_sigmoid(g0) * acc[ai][1][m][0][j]; v1[j] = g1 * fast_sigmoid(g1) * acc[ai][1][m][1][j]; }
                *(pg8::u32x4*)(HID + (size_t)(row0 + ai * 128 + m * 16) * 512 + col0) = pack8(v0, v1); }
    }
};
struct FEpiMoe2 {
    static constexpr bool PERM = true;
    bf16* Y2; const int* list; const float* gate;
    __device__ __forceinline__ void operator()(const pg8::f32x4 (&acc)[2][2][4][2], const pg8::Unit& u, int wr, int wc, int fr, int fq) const {
        const int e = u.ex & 255, mt = u.ex >> 8; const int* lp = list + (size_t)e * LIST_CAP + mt * 256;
        const int col0 = u.pn * 256 + wc * 32 + 8 * fq;
#pragma unroll
        for (int ai = 0; ai < 2; ++ai)
#pragma unroll
            for (int m = 0; m < 4; ++m) { const int r = ai * 128 + wr * 64 + m * 16 + fr;
                if (r < u.nrow) { const int asg = lp[r]; const float gt = gate[asg]; bf16* rowp = Y2 + (size_t)asg * D + col0;
#pragma unroll
                    for (int bj = 0; bj < 2; ++bj) *(pg8::u32x4*)(rowp + bj * 128) = pack8(acc[ai][bj][m][0] * gt, acc[ai][bj][m][1] * gt); } }
    }
};
__device__ __forceinline__ int moe_prefix(const int* cnt, volatile LAS int* tp, int tid) {
    if (tid == 0) { int acc = 0; for (int e = 0; e < NE; ++e) { tp[e] = acc; acc += (cnt[e] + 255) >> 8; } tp[NE] = acc; }
    __syncthreads();
    return __builtin_amdgcn_readfirstlane(tp[NE]);
}


__device__ __forceinline__ void load16bf(const bf16* ptr, float (&v)[16]) {
    const pg8::u32x4 a = *(const pg8::u32x4*)ptr, b = *(const pg8::u32x4*)(ptr + 8);
    pg8::f32x4 x0, x1, x2, x3; unpack8(a, x0, x1); unpack8(b, x2, x3);
#pragma unroll
    for (int j = 0; j < 4; ++j) { v[j] = x0[j]; v[4 + j] = x1[j]; v[8 + j] = x2[j]; v[12 + j] = x3[j]; }
}
__device__ __forceinline__ void store16bf(bf16* ptr, const float (&v)[16]) {
    pg8::u32x4 a, b;
    a.x = pk2(v[0], v[1]); a.y = pk2(v[2], v[3]); a.z = pk2(v[4], v[5]); a.w = pk2(v[6], v[7]);
    b.x = pk2(v[8], v[9]); b.y = pk2(v[10], v[11]); b.z = pk2(v[12], v[13]); b.w = pk2(v[14], v[15]);
    *(pg8::u32x4*)ptr = a; *(pg8::u32x4*)(ptr + 8) = b;
}
__device__ __forceinline__ void ln16(float (&v)[16], const float* g, const float* b, int c0) {
    float s = 0.f;
#pragma unroll
    for (int j = 0; j < 16; ++j) s += v[j];
    const float mean = wave_sum(s) * (1.f / D); float q = 0.f;
#pragma unroll
    for (int j = 0; j < 16; ++j) { v[j] -= mean; q += v[j] * v[j]; }
    const float rstd = 1.f / sqrtf(wave_sum(q) * (1.f / D) + LN_EPS);
#pragma unroll
    for (int j4 = 0; j4 < 4; ++j4) { const pg8::f32x4 gg = *(const pg8::f32x4*)(g + c0 + 4 * j4), bb = *(const pg8::f32x4*)(b + c0 + 4 * j4);
#pragma unroll
        for (int j = 0; j < 4; ++j) v[4 * j4 + j] = v[4 * j4 + j] * rstd * gg[j] + bb[j]; }
}
template <int L> __device__ __forceinline__ void router_phase(const Frame& F, const P& p, int gw, int NGW) {
    const bf16* R1 = (const bf16*)(p.ws + WS_R1); bf16* Hb = (bf16*)(p.ws + WS_HB);
    const float* g = p.in[L ? I_L1LN1G : I_L0LN1G]; const float* bb = p.in[L ? I_L1LN1B : I_L0LN1B];
    const float* wc = p.in[L ? I_M1WC : I_M0WC]; const float* bc = p.in[L ? I_M1BC : I_M0BC];
    const float* wf = p.in[L ? I_M1WF : I_M0WF]; const float* bfi = p.in[L ? I_M1BF : I_M0BF];
    int* cnt = (int*)(p.ws + WS_CTL) + (L ? CW_CNT1 : CW_CNT0);
    int* list = (int*)(p.ws + WS_ROUTE); float* gate = (float*)(p.ws + WS_GATE);
    const int lane = F.lane, c0 = lane * 16;
    for (int r = gw; r < MR; r += NGW) {
        float v[16]; load16bf(R1 + (size_t)r * D + c0, v);
        ln16(v, g, bb, c0);
#pragma unroll
        for (int j = 0; j < 16; ++j) v[j] = bf2f(f2bf(v[j]));
        store16bf(Hb + (size_t)r * D + c0, v);
        float lc[4] = {0.f, 0.f, 0.f, 0.f};
#pragma unroll
        for (int j = 0; j < 16; ++j) { const pg8::f32x4 w = *(const pg8::f32x4*)(wc + (size_t)(c0 + j) * 4);
#pragma unroll
            for (int c4 = 0; c4 < 4; ++c4) lc[c4] += v[j] * w[c4]; }
#pragma unroll
        for (int c4 = 0; c4 < 4; ++c4) lc[c4] = wave_sum(lc[c4]) + bc[c4];
        int grp = 0; float mxc = lc[0];
#pragma unroll
        for (int c4 = 1; c4 < 4; ++c4) if (lc[c4] > mxc) { mxc = lc[c4]; grp = c4; }
        float se = 0.f;
#pragma unroll
        for (int c4 = 0; c4 < 4; ++c4) se += expf(lc[c4] - mxc);
        const float pgrp = 1.f / se;
        float lf[8] = {0.f, 0.f, 0.f, 0.f, 0.f, 0.f, 0.f, 0.f};
        const float* wfg = wf + (size_t)grp * D * 8;
#pragma unroll
        for (int j = 0; j < 16; ++j) { const pg8::f32x4 w0 = *(const pg8::f32x4*)(wfg + (size_t)(c0 + j) * 8), w1 = *(const pg8::f32x4*)(wfg + (size_t)(c0 + j) * 8 + 4);
#pragma unroll
            for (int e4 = 0; e4 < 4; ++e4) { lf[e4] += v[j] * w0[e4]; lf[4 + e4] += v[j] * w1[e4]; } }
#pragma unroll
        for (int e8 = 0; e8 < 8; ++e8) lf[e8] = wave_sum(lf[e8]) + bfi[grp * 8 + e8];
        int i0 = 0; float v0 = lf[0];
#pragma unroll
        for (int e8 = 1; e8 < 8; ++e8) if (lf[e8] > v0) { v0 = lf[e8]; i0 = e8; }
        int i1 = 0; float v1 = -1e30f;
#pragma unroll
        for (int e8 = 0; e8 < 8; ++e8) if (e8 != i0 && lf[e8] > v1) { v1 = lf[e8]; i1 = e8; }
        const float e1 = expf(v1 - v0); const float g0 = pgrp / (1.f + e1), g1 = pgrp * e1 / (1.f + e1);
        if (lane == 0) {
            const int ea = grp * 8 + i0, eb = grp * 8 + i1;
            const int pa = atomicAdd(&cnt[ea], 1); list[(size_t)ea * LIST_CAP + pa] = r * 2; gate[r * 2] = g0;
            const int pb = atomicAdd(&cnt[eb], 1); list[(size_t)eb * LIST_CAP + pb] = r * 2 + 1; gate[r * 2 + 1] = g1;
        }
    }
}
template <int L> __device__ __forceinline__ void combine_phase(const Frame& F, const P& p, int gw, int NGW) {
    bf16* Hb = (bf16*)(p.ws + WS_HB); const bf16* Y2 = (const bf16*)(p.ws + WS_Z);
    const float* g = p.in[L ? I_L1LN2G : I_L0LN2G]; const float* bb = p.in[L ? I_L1LN2B : I_L0LN2B];
    const int lane = F.lane, c0 = lane * 16;
    for (int r = gw; r < (L ? MX : MR); r += NGW) {
        float v[16], a[16], b[16]; load16bf(Hb + (size_t)r * D + c0, v); load16bf(Y2 + (size_t)(2 * r) * D + c0, a); load16bf(Y2 + (size_t)(2 * r + 1) * D + c0, b);
#pragma unroll
        for (int j = 0; j < 16; ++j) v[j] = ALPHA * v[j] + a[j] + b[j];
        ln16(v, g, bb, c0);
        if (L == 0) store16bf(Hb + (size_t)r * D + c0, v);
        else {
#pragma unroll
            for (int j4 = 0; j4 < 4; ++j4) *(pg8::f32x4*)(p.out + (size_t)r * D + c0 + 4 * j4) = (pg8::f32x4){v[4 * j4], v[4 * j4 + 1], v[4 * j4 + 2], v[4 * j4 + 3]};
        }
    }
}

namespace att {
typedef float f32x16 __attribute__((ext_vector_type(16)));
typedef short s16x4 __attribute__((ext_vector_type(4)));
typedef short v4i16_t __attribute__((ext_vector_type(4)));
constexpr int KS = 144, KBYTES = 64 * KS;
constexpr int VS = 320, VBYTES = 64 * VS;
constexpr int STG = 2 * KBYTES + VBYTES;
constexpr float THR = 6.0f;
__device__ __forceinline__ int crow(int r, int hi) { return (r & 3) + 8 * (r >> 2) + 4 * hi; }
__device__ __forceinline__ s16x4 vtr(const LAS unsigned char* p) { return __builtin_bit_cast(s16x4, __builtin_amdgcn_ds_read_tr16_b64_v4i16((LAS v4i16_t*)p)); }

__device__ __forceinline__ void attn_unit(const Frame& F, const P& p, LAS unsigned char* lds, int b, int h, int qb, bool is_meta, float lam) {
    const bf16* Z = (const bf16*)(p.ws + WS_Z); bf16* YM = (bf16*)(p.ws + WS_YM);
    const int tid = F.tid, lane = F.lane, wid = F.wave, qsub = wid & 3, c = wid >> 2, r32 = lane & 31, hi = lane >> 5;
    const bool wave_active = is_meta ? (qsub == 0) : true;
    const int ntiles = is_meta ? 1 : 2 * qb + 3;
    const int my_ntiles = is_meta ? 1 : 2 * qb + 2 + (qsub >= 2 ? 1 : 0);
    const size_t qrow = is_meta ? (size_t)(MX + (r32 < 16 ? r32 : 15)) : (size_t)b * SEQ + qb * 128 + qsub * 32 + r32;
    bf16x8 qf[4];
#pragma unroll
    for (int d = 0; d < 4; ++d) qf[d] = *(const bf16x8*)(Z + qrow * NZ0 + 512 + h * 128 + c * 64 + d * 16 + hi * 8);
    v4u kreg[2], vreg[2];
    auto gload = [&](int t) {
#pragma unroll
        for (int i = 0; i < 2; ++i) { const int id = tid + 512 * i, row = id >> 4, ch = id & 15;
            long grow = t == 0 ? (row < 16 ? (long)(MX + row) : -1L) : (long)b * SEQ + 64 * (t - 1) + row;
            if (grow >= 0) { kreg[i] = *(const v4u*)(Z + (size_t)grow * NZ0 + 1024 + h * 128 + ch * 8); vreg[i] = *(const v4u*)(Z + (size_t)grow * NZ0 + 1536 + h * 128 + ch * 8); }
            else { kreg[i] = (v4u){0u, 0u, 0u, 0u}; vreg[i] = (v4u){0u, 0u, 0u, 0u}; } }
    };
    auto sstore = [&](int buf) {
#pragma unroll
        for (int i = 0; i < 2; ++i) { const int id = tid + 512 * i, row = id >> 4, ch = id & 15;
            *(LAS v4u*)(lds + buf * STG + (ch >> 3) * KBYTES + row * KS + (ch & 7) * 16) = kreg[i];
            *(LAS v4u*)(lds + buf * STG + 2 * KBYTES + row * VS + ch * 16) = vreg[i]; }
    };
    f32x16 o[4];
#pragma unroll
    for (int d = 0; d < 4; ++d) o[d] = f32x16{};
    float m = -1e30f, l = 0.f;
    gload(0); sstore(0); __syncthreads();
#pragma unroll 1
    for (int t = 0; t < ntiles; ++t) {
        const int buf = t & 1;
        if (t + 1 < ntiles) gload(t + 1);
        if (wave_active && t < my_ntiles) {
            const LAS unsigned char* Kc = lds + buf * STG + c * KBYTES + r32 * KS + hi * 16;
            f32x16 p0 = f32x16{}, p1 = f32x16{};
#pragma unroll
            for (int d = 0; d < 4; ++d) {
                const bf16x8 k0 = *(const LAS bf16x8*)(Kc + d * 32), k1 = *(const LAS bf16x8*)(Kc + 32 * KS + d * 32);
                p0 = __builtin_amdgcn_mfma_f32_32x32x16_bf16(k0, qf[d], p0, 0, 0, 0);
                p1 = __builtin_amdgcn_mfma_f32_32x32x16_bf16(k1, qf[d], p1, 0, 0, 0);
            }
            __builtin_amdgcn_sched_barrier(0);
            if (t == 0) {
#pragma unroll
                for (int r = 0; r < 16; ++r) { if (r >= 8) p0[r] = -1e30f; p1[r] = -1e30f; }
            }
            float rm = fmaxf(p0[0], p1[0]);
#pragma unroll
            for (int r = 1; r < 16; ++r) rm = fmaxf(rm, fmaxf(p0[r], p1[r]));
            rm = fmaxf(rm, __shfl_xor(rm, 32));
            if (__any(rm > m + THR)) {
                const float mn = fmaxf(m, rm), alpha = __builtin_amdgcn_exp2f(m - mn);
                m = mn; l *= alpha;
#pragma unroll
                for (int r = 0; r < 16; ++r) { const float ar = __shfl(alpha, crow(r, hi));
#pragma unroll
                    for (int d = 0; d < 4; ++d) o[d][r] *= ar; }
            }
            float ls = 0.f;
#pragma unroll
            for (int r = 0; r < 16; ++r) { p0[r] = __builtin_amdgcn_exp2f(p0[r] - m); p1[r] = __builtin_amdgcn_exp2f(p1[r] - m); ls += p0[r] + p1[r]; }
            l += ls;
            bf16x8 pa[4];
            { v4u w;
              w.x = pg8::cvt_pk_bf16(p0[0], p0[1]); w.y = pg8::cvt_pk_bf16(p0[2], p0[3]); w.z = pg8::cvt_pk_bf16(p0[4], p0[5]); w.w = pg8::cvt_pk_bf16(p0[6], p0[7]); pa[0] = __builtin_bit_cast(bf16x8, w);
              w.x = pg8::cvt_pk_bf16(p0[8], p0[9]); w.y = pg8::cvt_pk_bf16(p0[10], p0[11]); w.z = pg8::cvt_pk_bf16(p0[12], p0[13]); w.w = pg8::cvt_pk_bf16(p0[14], p0[15]); pa[1] = __builtin_bit_cast(bf16x8, w);
              w.x = pg8::cvt_pk_bf16(p1[0], p1[1]); w.y = pg8::cvt_pk_bf16(p1[2], p1[3]); w.z = pg8::cvt_pk_bf16(p1[4], p1[5]); w.w = pg8::cvt_pk_bf16(p1[6], p1[7]); pa[2] = __builtin_bit_cast(bf16x8, w);
              w.x = pg8::cvt_pk_bf16(p1[8], p1[9]); w.y = pg8::cvt_pk_bf16(p1[10], p1[11]); w.z = pg8::cvt_pk_bf16(p1[12], p1[13]); w.w = pg8::cvt_pk_bf16(p1[14], p1[15]); pa[3] = __builtin_bit_cast(bf16x8, w); }
            __builtin_amdgcn_sched_barrier(0);
            const LAS unsigned char* Vb = lds + buf * STG + 2 * KBYTES + (4 * hi + ((lane & 15) >> 2)) * VS + (16 * ((lane >> 4) & 1) + 4 * (lane & 3)) * 2;
#pragma unroll
            for (int d = 0; d < 4; ++d)
#pragma unroll
                for (int s = 0; s < 4; ++s) {
                    const s16x4 lo = vtr(Vb + (16 * s) * VS + d * 64), hh = vtr(Vb + (16 * s + 8) * VS + d * 64);
                    const bf16x8 vf = (bf16x8){lo[0], lo[1], lo[2], lo[3], hh[0], hh[1], hh[2], hh[3]};
                    o[d] = __builtin_amdgcn_mfma_f32_32x32x16_bf16(pa[s], vf, o[d], 0, 0, 0);
                    if (s == 3) __builtin_amdgcn_sched_barrier(0);
                }
        }
        if (t + 1 < ntiles) sstore(buf ^ 1);
        __syncthreads();
    }
    const float lt = l + __shfl_xor(l, 32);
    const float inv = (c == 1 ? lam : 1.f) / lt;
#pragma unroll
    for (int r = 0; r < 16; ++r) { const float ir = __shfl(inv, crow(r, hi));
#pragma unroll
        for (int d = 0; d < 4; ++d) o[d][r] *= ir; }
    LAS float* ex = (LAS float*)(lds) + qsub * 4224;
    if (c == 1 && wave_active) {
#pragma unroll
        for (int d = 0; d < 4; ++d)
#pragma unroll
            for (int r = 0; r < 16; ++r) ex[(d * 16 + r) * 64 + lane] = o[d][r];
    }
    __syncthreads();
    if (c == 0 && wave_active) {
#pragma unroll
        for (int d = 0; d < 4; ++d)
#pragma unroll
            for (int r = 0; r < 16; ++r) o[d][r] -= ex[(d * 16 + r) * 64 + lane];
        LDS_WAIT(); asm volatile("" ::: "memory");
#pragma unroll
        for (int d = 0; d < 4; ++d)
#pragma unroll
            for (int r = 0; r < 16; ++r) ex[(4 * hi) * 132 + r32 + ((r & 3) + 8 * (r >> 2)) * 132 + 32 * d] = o[d][r];
        LDS_WAIT(); asm volatile("" ::: "memory");
        const int q = r32, half = hi;
        float ss = 0.f;
#pragma unroll
        for (int k = 0; k < 16; ++k) { const pg8::f32x4 x = *(const LAS pg8::f32x4*)(ex + q * 132 + 64 * half + 4 * k);
            ss += (x[0] * x[0] + x[1] * x[1]) + (x[2] * x[2] + x[3] * x[3]); }
        ss += __shfl_xor(ss, 32);
        const float rs = (1.f - LAM_INIT) / sqrtf(ss * (1.f / 128.f) + LN_EPS);
        const float* sg = p.in[I_SUBLN] + 64 * half;
        const size_t orow = is_meta ? (size_t)(MX + q) : (size_t)b * SEQ + qb * 128 + qsub * 32 + q;
        if (!is_meta || q < 16) {
            bf16* op = YM + orow * D + 512 + h * 128 + 64 * half;
#pragma unroll
            for (int k = 0; k < 8; ++k) { const pg8::f32x4 g0 = *(const pg8::f32x4*)(sg + 8 * k), g1 = *(const pg8::f32x4*)(sg + 8 * k + 4);
                const pg8::f32x4 x0 = *(const LAS pg8::f32x4*)(ex + q * 132 + 64 * half + 8 * k);
                const pg8::f32x4 x1 = *(const LAS pg8::f32x4*)(ex + q * 132 + 64 * half + 8 * k + 4);
                *(pg8::u32x4*)(op + 8 * k) = pack8(x0 * g0 * rs, x1 * g1 * rs);
                asm volatile("" ::: "memory"); }
        }
    }
    __syncthreads();
}

__device__ __forceinline__ void attn_phase(const Frame& F, const P& p, LAS unsigned char* lds) {
    const float l1 = wave_sum(p.in[I_LQ1][F.lane] * p.in[I_LK1][F.lane]);
    const float l2 = wave_sum(p.in[I_LQ2][F.lane] * p.in[I_LK2][F.lane]);
    const float lam = expf(l1) - expf(l2) + LAM_INIT;
    const int npair = (F.vcu < 256) ? 1 : 0;
    const int nun = 2 * npair + (F.vcu < 4 ? 1 : 0);
#pragma unroll 1
    for (int u = 0; u < nun; ++u) {
        const int pr = F.vcu, bh = pr >> 3, s = pr & 7;
        const bool is_meta = (u == 2 * npair);
        const int b = is_meta ? 0 : (bh >> 2), h = is_meta ? F.vcu : (bh & 3), qb = is_meta ? 0 : (u == 0 ? 15 - s : s);
        attn_unit(F, p, lds, b, h, qb, is_meta, lam);
    }
}
}
namespace lru {
constexpr size_t WS_XC = WS_MOE0;
__device__ __forceinline__ size_t seq_row(int b, int s) { return s < NMETA ? (size_t)(MX + s) : (size_t)b * SEQ + (s - NMETA); }

__device__ __forceinline__ void conv_phase(const Frame& F, const P& p) {
    const bf16* Z = (const bf16*)(p.ws + WS_Z); bf16* XC = (bf16*)(p.ws + WS_XC);
    const float* cw = p.in[I_CONVW]; const float* cb = p.in[I_CONVB];
    const int gt = (F.vcu * NWAVES + F.wave) * 64 + F.lane, NGT = F.G * NWAVES * 64;
    for (int it = gt; it < MR * 160; it += NGT) {
        const int r = it / 160, c8 = (it % 160) * 8;
        int b, s; if (r >= MX) { b = 0; s = r - MX; } else { b = r >> 11; s = NMETA + (r & 2047); }
        float acc[8];
        { const pg8::f32x4 b0 = *(const pg8::f32x4*)(cb + c8), b1 = *(const pg8::f32x4*)(cb + c8 + 4);
#pragma unroll
          for (int j = 0; j < 4; ++j) { acc[j] = b0[j]; acc[4 + j] = b1[j]; } }
#pragma unroll
        for (int j = 0; j < 4; ++j) { const int sj = s - 3 + j;
            if (sj >= 0) { pg8::f32x4 x0, x1; unpack8(*(const pg8::u32x4*)(Z + seq_row(b, sj) * NZ1 + DRNN + c8), x0, x1);
                const pg8::f32x4 w0 = *(const pg8::f32x4*)(cw + j * DRNN + c8), w1 = *(const pg8::f32x4*)(cw + j * DRNN + c8 + 4);
#pragma unroll
                for (int e = 0; e < 4; ++e) { acc[e] += x0[e] * w0[e]; acc[4 + e] += x1[e] * w1[e]; } } }
        *(pg8::u32x4*)(XC + (size_t)r * DRNN + c8) = pack8((pg8::f32x4){acc[0], acc[1], acc[2], acc[3]}, (pg8::f32x4){acc[4], acc[5], acc[6], acc[7]});
    }
}

__device__ __forceinline__ void scan_unit(const Frame& F, const P& p, int b, int n, int j) {
    const bf16* Z = (const bf16*)(p.ws + WS_Z); const bf16* XC = (const bf16*)(p.ws + WS_XC); bf16* Y1 = (bf16*)(p.ws + WS_YM);
    const bf16* WAX = (const bf16*)(p.ws + WB_WAX);
    const int lane = F.lane, col = lane & 15, grp = lane >> 4, ch = n * 128 + 16 * j + col;
    bf16x8 bw[2][4];
#pragma unroll
    for (int g = 0; g < 2; ++g)
#pragma unroll
        for (int ks = 0; ks < 4; ++ks) bw[g][ks] = *(const bf16x8*)(WAX + ((size_t)(n * 2 + g) * 128 + 16 * j + col) * 128 + 32 * ks + 8 * grp);
    bf16x8 ident;
    { const int kl = 16 * (j & 1) + col;
#pragma unroll
      for (int e = 0; e < 8; ++e) ident[e] = (grp == (kl >> 3) && e == (kl & 7)) ? (short)0x3F80 : (short)0; }
    const float ba = p.in[I_BA][ch], bx = p.in[I_BX][ch];
    const float lam = p.in[I_LAM][ch];
    const float c8 = -8.f * log1pf(expf(-lam)) * 1.4426950408889634f;
    float carry = 0.f;
    const int ksx = j >> 1;
#pragma unroll 1
    for (int T = 0; T < 33; ++T) {
        f32x4 accA[4], accX[4], xb[4], gg[4];
#pragma unroll
        for (int mt = 0; mt < 4; ++mt) {
            int s = 64 * T + 16 * mt + col; if (s > NMETA + SEQ - 1) s = NMETA + SEQ - 1;
            const size_t row = seq_row(b, s);
            bf16x8 xa[4];
#pragma unroll
            for (int ks = 0; ks < 4; ++ks) xa[ks] = *(const bf16x8*)(XC + row * DRNN + n * 128 + 32 * ks + 8 * grp);
            const bf16x8 ga = *(const bf16x8*)(Z + row * NZ1 + n * 128 + 32 * ksx + 8 * grp);
            f32x4 a = {0.f, 0.f, 0.f, 0.f}, x = {0.f, 0.f, 0.f, 0.f};
#pragma unroll
            for (int ks = 0; ks < 4; ++ks) { a = __builtin_amdgcn_mfma_f32_16x16x32_bf16(xa[ks], bw[0][ks], a, 0, 0, 0); x = __builtin_amdgcn_mfma_f32_16x16x32_bf16(xa[ks], bw[1][ks], x, 0, 0, 0); }
            accA[mt] = a; accX[mt] = x;
            const bf16x8 xsel = ksx == 0 ? xa[0] : ksx == 1 ? xa[1] : ksx == 2 ? xa[2] : xa[3];
            xb[mt] = __builtin_amdgcn_mfma_f32_16x16x32_bf16(xsel, ident, (f32x4){0.f, 0.f, 0.f, 0.f}, 0, 0, 0);
            gg[mt] = __builtin_amdgcn_mfma_f32_16x16x32_bf16(ga, ident, (f32x4){0.f, 0.f, 0.f, 0.f}, 0, 0, 0);
        }
        float hl[4][4], Ac[4][4], Aex[4], hex[4], Atot[4], htot[4];
#pragma unroll
        for (int mt = 0; mt < 4; ++mt) {
            float ar = 1.f, hr = 0.f;
#pragma unroll
            for (int k = 0; k < 4; ++k) {
                const int s = 64 * T + 16 * mt + 4 * grp + k;
                const float rg = fast_sigmoid(accA[mt][k] + ba), ig = fast_sigmoid(accX[mt][k] + bx);
                float a = __builtin_amdgcn_exp2f(c8 * rg);
                float bt = sqrtf(fmaxf(1.f - a * a, 0.f)) * (ig * xb[mt][k]);
                if (s >= NMETA + SEQ) { a = 1.f; bt = 0.f; }
                hr = a * hr + bt; ar = ar * a; hl[mt][k] = hr; Ac[mt][k] = ar;
            }
            float Ai = ar, hi_ = hr;
            { const float A1 = __shfl_up(Ai, 16), h1 = __shfl_up(hi_, 16); if (grp >= 1) { hi_ = Ai * h1 + hi_; Ai = Ai * A1; } }
            { const float A2 = __shfl_up(Ai, 32), h2 = __shfl_up(hi_, 32); if (grp >= 2) { hi_ = Ai * h2 + hi_; Ai = Ai * A2; } }
            const float Ae = __shfl_up(Ai, 16), he = __shfl_up(hi_, 16);
            Aex[mt] = grp >= 1 ? Ae : 1.f; hex[mt] = grp >= 1 ? he : 0.f;
            Atot[mt] = __shfl(Ai, 48 + col); htot[mt] = __shfl(hi_, 48 + col);
        }
#pragma unroll
        for (int mt = 0; mt < 4; ++mt) {
            const float cin = Aex[mt] * carry + hex[mt];
#pragma unroll
            for (int k = 0; k < 4; ++k) {
                const int s = 64 * T + 16 * mt + 4 * grp + k;
                const float h = hl[mt][k] + Ac[mt][k] * cin;
                if (s < NMETA + SEQ && (s >= NMETA || b == 0)) Y1[seq_row(b, s) * DRNN + ch] = f2bf(gg[mt][k] * h);
            }
            carry = Atot[mt] * carry + htot[mt];
        }
    }
}
__device__ __forceinline__ void scan_phase(const Frame& F, const P& p) {
    const int gw = F.vcu * NWAVES + F.wave, NGW = F.G * NWAVES;
    for (int u = gw; u < 640 * 3; u += NGW) { if (u % 3) continue; const int id = u / 3; scan_unit(F, p, id / 80, (id % 80) / 8, id % 8); }
}
}
namespace s5 {
typedef float f32x16 __attribute__((ext_vector_type(16)));
constexpr size_t T_K = 19 * MiB, T_A = 19 * MiB + 512 * 1024, T_Q = 20 * MiB, T_P = 24 * MiB;
constexpr int L_U = 0, L_K = 65536, L_E = 81920, L_S = 114688;
__device__ __forceinline__ int crow(int r, int hi) { return (r & 3) + 8 * (r >> 2) + 4 * hi; }

struct Disc { float lrdt, lidt, ar, ai; float bbr[16], bbi[16]; };
__device__ __forceinline__ void disc(const P& p, int g, int lane, Disc& d) {
    const float dt = expf(p.in[I_LOGDT][g]);
    const float lr = fminf(p.in[I_LRE][g * 64 + lane], -1e-4f), li = p.in[I_LIM][g * 64 + lane];
    d.lrdt = lr * dt; d.lidt = li * dt;
    const float mag = expf(d.lrdt); d.ar = mag * cosf(d.lidt); d.ai = mag * sinf(d.lidt);
    const float den = lr * lr + li * li, nr = d.ar - 1.f, ni = d.ai;
    const float fr = (nr * lr + ni * li) / den, fi = (ni * lr - nr * li) / den;
#pragma unroll
    for (int h = 0; h < 16; ++h) { const float br = p.in[I_BRE][((size_t)g * 64 + lane) * 16 + h], bi = p.in[I_BIM][((size_t)g * 64 + lane) * 16 + h];
        d.bbr[h] = fr * br - fi * bi; d.bbi[h] = fr * bi + fi * br; }
}
__device__ __forceinline__ void table_item(const P& p, int g, int tau, LAS float* scr, int lane) {
    Disc d; disc(p, g, lane, d);
    const float mag = expf(d.lrdt * (float)tau); float sn, cs; sincosf(d.lidt * (float)tau, &sn, &cs);
    const float pr = mag * cs, pi = mag * sn;
    bf16* Kt = (bf16*)(p.ws + T_K); bf16* Qg = (bf16*)(p.ws + T_Q); bf16* Pg = (bf16*)(p.ws + T_P); float* A32 = (float*)(p.ws + T_A);
    if (tau == 32) { A32[(g * 64 + lane) * 2] = pr; A32[(g * 64 + lane) * 2 + 1] = pi; }
    if (tau >= 1) {
#pragma unroll
        for (int h = 0; h < 16; ++h) { const float cr = p.in[I_CRE][((size_t)g * 16 + h) * 64 + lane], ci = p.in[I_CIM][((size_t)g * 16 + h) * 64 + lane];
            bf16* row = Pg + ((size_t)g * 512 + (tau - 1) * 16 + h) * 128;
            row[lane] = f2bf(cr * pr - ci * pi); row[64 + lane] = f2bf(-(cr * pi + ci * pr)); }
    }
    if (tau <= 31) {
        float pbr[16], pbi[16];
#pragma unroll
        for (int h = 0; h < 16; ++h) { pbr[h] = pr * d.bbr[h] - pi * d.bbi[h]; pbi[h] = pr * d.bbi[h] + pi * d.bbr[h]; }
        bf16* qre = Qg + ((size_t)g * 128 + lane) * 512 + (31 - tau) * 16; bf16* qim = Qg + ((size_t)g * 128 + 64 + lane) * 512 + (31 - tau) * 16;
        store16bf(qre, pbr); store16bf(qim, pbi);
#pragma unroll
        for (int h = 0; h < 16; ++h) { scr[lane * 33 + h] = pbr[h]; scr[lane * 33 + 16 + h] = pbi[h]; }
        LDS_WAIT(); asm volatile("" ::: "memory");
        const int h = lane >> 2, hq = (lane & 3) * 4;
        float acc[4] = {0.f, 0.f, 0.f, 0.f};
        for (int pp = 0; pp < 64; ++pp) { const float cr = p.in[I_CRE][((size_t)g * 16 + h) * 64 + pp], ci = p.in[I_CIM][((size_t)g * 16 + h) * 64 + pp];
#pragma unroll
            for (int e = 0; e < 4; ++e) acc[e] += cr * scr[pp * 33 + hq + e] - ci * scr[pp * 33 + 16 + hq + e]; }
        bf16* kp = Kt + ((size_t)g * 32 + tau) * 256 + h * 16 + hq;
        *(unsigned long long*)kp = (unsigned long long)pk2(acc[0], acc[1]) | ((unsigned long long)pk2(acc[2], acc[3]) << 32);
        LDS_WAIT(); asm volatile("" ::: "memory");
    }
}

__device__ __forceinline__ int u_off(int token, int hbyte) { return ((token * 32 + hbyte) ^ (((token >> 5) & 15) << 4)); }
__device__ __forceinline__ int s_off(int c, int kbyte) { return ((c * 256 + kbyte) ^ ((c & 15) << 4)); }

__device__ __forceinline__ void s5_unit(const Frame& F, const P& p, LAS unsigned char* lds, int b, int g) {
    const bf16* Z = (const bf16*)(p.ws + WS_Z); bf16* YP = (bf16*)(p.ws + WS_YP);
    const bf16* Kt = (const bf16*)(p.ws + T_K) + (size_t)g * 32 * 256; const bf16* Qg = (const bf16*)(p.ws + T_Q) + (size_t)g * 128 * 512;
    const bf16* Pg = (const bf16*)(p.ws + T_P) + (size_t)g * 512 * 128; const float* A32 = (const float*)(p.ws + T_A) + (size_t)g * 128;
    const int tid = F.tid, lane = F.lane, wid = F.wave, r32 = lane & 31, hi = lane >> 5;
#pragma unroll
    for (int i = 0; i < 8; ++i) { const int id = tid + 512 * i, tok = id >> 1, half = id & 1;
        const v4u v = *(const v4u*)(Z + ((size_t)b * SEQ + tok) * NZ0 + g * 16 + half * 8);
        *(LAS v4u*)(lds + L_U + u_off(tok, half * 16)) = v; }
#pragma unroll
    for (int i = 0; i < 2; ++i) { const int id = tid + 512 * i; *(LAS v4u*)(lds + L_K + id * 16) = *(const v4u*)(Kt + id * 8); }
    LAS float* msc = (LAS float*)(lds + L_E);
    if (wid == 0) {
        Disc d; disc(p, g, lane, d);
        if (b == 0) for (int i = lane; i < 1024; i += 64) { msc[256 + i] = p.in[I_CRE][(size_t)g * 1024 + i]; msc[256 + 1024 + i] = p.in[I_CIM][(size_t)g * 1024 + i]; }
        float hr = 0.f, hm = 0.f;
        for (int s = 0; s < NMETA; ++s) {
            if (lane < 16) msc[lane] = bf2f(Z[(size_t)(MX + s) * NZ0 + g * 16 + lane]);
            LDS_WAIT(); asm volatile("" ::: "memory");
            float bur = 0.f, bui = 0.f;
#pragma unroll
            for (int h = 0; h < 16; ++h) { const float u = msc[h]; bur += u * d.bbr[h]; bui += u * d.bbi[h]; }
            const float nhr = d.ar * hr - d.ai * hm + bur, nhi = d.ar * hm + d.ai * hr + bui; hr = nhr; hm = nhi;
            if (b == 0) {
                msc[16 + lane] = hr; msc[80 + lane] = hm;
                LDS_WAIT(); asm volatile("" ::: "memory");
                const int h = lane >> 2, q = lane & 3; float y = 0.f;
                for (int pp = q * 16; pp < q * 16 + 16; ++pp) y += msc[16 + pp] * msc[256 + h * 64 + pp] - msc[80 + pp] * msc[256 + 1024 + h * 64 + pp];
                y += __shfl_xor(y, 1); y += __shfl_xor(y, 2);
                if (q == 0) { y += p.in[I_S5D][g * 16 + h] * msc[h]; YP[(size_t)(MX + s) * 512 + g * 16 + h] = f2bf(gelu_tanh(y)); }
            }
            LDS_WAIT(); asm volatile("" ::: "memory");
        }
        *(LAS bf16*)(lds + L_S + s_off(0, lane * 2)) = f2bf(hr); *(LAS bf16*)(lds + L_S + s_off(0, (64 + lane) * 2)) = f2bf(hm);
        msc[16 + lane] = hr; msc[80 + lane] = hm;
    }
    __syncthreads();
    float s0r = 0.f, s0i = 0.f;
    if (wid == 0) { s0r = msc[16 + lane]; s0i = msc[80 + lane]; }
    __syncthreads();
    {
        const int mt = wid & 3, nt = wid >> 2, c = 32 * nt + r32;
        f32x16 acc = f32x16{};
        const bf16* qa = Qg + (size_t)(32 * mt + r32) * 512 + hi * 8;
#pragma unroll 4
        for (int ks = 0; ks < 32; ++ks) {
            const bf16x8 a = *(const bf16x8*)(qa + ks * 16);
            const bf16x8 bq = *(const LAS bf16x8*)(lds + L_U + u_off(32 * c + ks, hi * 16));
            acc = __builtin_amdgcn_mfma_f32_32x32x16_bf16(a, bq, acc, 0, 0, 0);
        }
        LAS float* E = (LAS float*)(lds + L_E);
#pragma unroll
        for (int r = 0; r < 16; ++r) E[c * 128 + 32 * mt + crow(r, hi)] = acc[r];
    }
    __syncthreads();
    if (wid == 0) {
        const float a32r = A32[lane * 2], a32i = A32[lane * 2 + 1];
        const LAS float* E = (const LAS float*)(lds + L_E);
        float sr = s0r, si = s0i;
        for (int c = 0; c < 63; ++c) {
            const float er = E[c * 128 + lane], ei = E[c * 128 + 64 + lane];
            const float nr = a32r * sr - a32i * si + er, ni = a32r * si + a32i * sr + ei; sr = nr; si = ni;
            *(LAS bf16*)(lds + L_S + s_off(c + 1, lane * 2)) = f2bf(sr); *(LAS bf16*)(lds + L_S + s_off(c + 1, (64 + lane) * 2)) = f2bf(si);
        }
    }
    __syncthreads();
#pragma unroll 1
    for (int q4 = 0; q4 < 4; ++q4) {
        const int i = (q4 & 1) ? 15 - wid : wid, nt = q4 >> 1, c = 32 * nt + r32;
        const int t = 2 * i + (r32 >> 4), h = r32 & 15;
        f32x16 acc = f32x16{};
        const bf16* pa = Pg + (size_t)(32 * i + r32) * 128 + hi * 8;
#pragma unroll
        for (int ks = 0; ks < 8; ++ks) {
            const bf16x8 a = *(const bf16x8*)(pa + ks * 16);
            const bf16x8 bq = *(const LAS bf16x8*)(lds + L_S + s_off(c, ks * 32 + hi * 16));
            acc = __builtin_amdgcn_mfma_f32_32x32x16_bf16(a, bq, acc, 0, 0, 0);
        }
#pragma unroll 2
        for (int s = 0; s <= 2 * i + 1; ++s) {
            const int tau = t - s;
            bf16x8 a = *(const LAS bf16x8*)(lds + L_K + ((tau < 0 ? 0 : tau) * 256 + h * 16 + hi * 8) * 2);
            if (tau < 0) a = (bf16x8){0, 0, 0, 0, 0, 0, 0, 0};
            const bf16x8 bq = *(const LAS bf16x8*)(lds + L_U + u_off(32 * c + s, hi * 16));
            acc = __builtin_amdgcn_mfma_f32_32x32x16_bf16(a, bq, acc, 0, 0, 0);
        }
#pragma unroll
        for (int rq = 0; rq < 4; ++rq) {
            const int tt = 2 * i + (rq >> 1), h0 = 8 * (rq & 1) + 4 * hi, tok = 32 * c + tt;
            const unsigned long long uu = *(const LAS unsigned long long*)(lds + L_U + u_off(tok, h0 * 2));
            const pg8::f32x4 dd = *(const pg8::f32x4*)(p.in[I_S5D] + g * 16 + h0);
            float y[4];
#pragma unroll
            for (int e = 0; e < 4; ++e) { const float u = bf2f((bf16)((uu >> (16 * e)) & 0xffffu)); y[e] = fast_gelu(acc[4 * rq + e] + dd[e] * u); }
            *(unsigned long long*)(YP + ((size_t)b * SEQ + tok) * 512 + g * 16 + h0) = (unsigned long long)pk2(y[0], y[1]) | ((unsigned long long)pk2(y[2], y[3]) << 32);
        }
    }
    __syncthreads();
}
__device__ __forceinline__ void s5_phase(const Frame& F, const P& p, LAS unsigned char* lds) {
#pragma unroll 1
    for (int u = F.vcu; u < 256; u += F.G) s5_unit(F, p, lds, u >> 5, u & 31);
}
}

typedef ArgsF Args;
typedef __attribute__((address_space(4))) const Args CArgs;
__device__ __forceinline__ void load_p(P& p, CArgs* q) {
    asm volatile("" : "+s"(q));
#pragma unroll
    for (int i = 0; i < 50; ++i) p.in[i] = q->p.in[i];
    p.out = q->p.out; p.ws = q->p.ws;
}

#ifndef PH_MASK
#define PH_MASK 0xFFFFFFFFu
#endif
#define IN(k) (((PH_MASK >> (k)) & 1u) && lo <= (k) && (k) < hi)
#define SEAM(k) do { if (IN(k) && IN((k) + 1)) xcd_barrier(bar); } while (0)
template <int L> __device__ __forceinline__ void moe_gemm_phases(const Frame& F, CArgs* ap0, unsigned* ctl, volatile LAS unsigned* MISC, const XcdBarrier& bar, int lo, int hi) {
        const int ph = L ? 15 : 7;
        if (IN(ph)) {
            P p; load_p(p, ap0);
            volatile LAS int* tp = (volatile LAS int*)(MISC + 16);
            const int* cnt = (const int*)ctl + (L ? CW_CNT1 : CW_CNT0);
            const int tiles = moe_prefix(cnt, tp, F.tid);
            MoeOrder<true, 4, 1024, 1024> S{(const char*)(p.ws + WS_HB), (const char*)(p.ws + (L ? WS_MOE1 : WS_MOE0) + MOE_WGU), (const int*)(p.ws + WS_ROUTE), cnt, tp, F.G, F.vcu, tiles * 4};
            FEpiMoe1 E{(bf16*)(p.ws + WS_YM)};
            pg8::gemm_phase<FEpiMoe1, MoeOrder<true, 4, 1024, 1024>, true>(F.lds, 1024, S, E);
        }
        SEAM(ph);
        if (IN(ph + 1)) {
            P p; load_p(p, ap0);
            volatile LAS int* tp = (volatile LAS int*)(MISC + 16);
            const int* cnt = (const int*)ctl + (L ? CW_CNT1 : CW_CNT0);
            const int tiles = moe_prefix(cnt, tp, F.tid);
            MoeOrder<false, 4, 512, 1024> S{(const char*)(p.ws + WS_YM), (const char*)(p.ws + (L ? WS_MOE1 : WS_MOE0) + MOE_WD), (const int*)(p.ws + WS_ROUTE), cnt, tp, F.G, F.vcu, tiles * 4};
            FEpiMoe2 E{(bf16*)(p.ws + WS_Z), (const int*)(p.ws + WS_ROUTE), (const float*)(p.ws + WS_GATE)};
            pg8::gemm_phase<FEpiMoe2, MoeOrder<false, 4, 512, 1024>, true>(F.lds, 512, S, E);
        }
        SEAM(ph + 1);
}
__global__ void __launch_bounds__(NWAVES * 64, 2) mk(Args args) {
    extern __shared__ __attribute__((aligned(16))) unsigned char lds_raw[];
    CArgs* ap0 = (CArgs*)__builtin_amdgcn_kernarg_segment_ptr();
    Frame F;
    F.lds = (LAS unsigned char*)lds_raw;
    F.tid = threadIdx.x; F.lane = F.tid & 63; F.wave = __builtin_amdgcn_readfirstlane(F.tid >> 6);
    F.G = gridDim.x; { const int bx = blockIdx.x; F.vcu = (F.G % 8 == 0) ? (bx % 8) * (F.G / 8) + bx / 8 : bx; }
    volatile LAS unsigned* MISC = (volatile LAS unsigned*)(F.lds + MISC_OFF);
    for (int u = F.tid; u < (LDS_BYTES - RING_BYTES) / 4; u += NWAVES * 64) ((LAS unsigned*)(F.lds + RING_BYTES))[u] = 0u;
    __syncthreads();
    unsigned* ctl = (unsigned*)(ap0->p.ws + WS_CTL);
    const bool multi = (ap0->ph_hi - ap0->ph_lo) > 1;
    XcdBarrier bar; bar.bar = ctl + CW_BAR + ap0->li * XCD_BAR_WORDS; bar.x = 0; bar.st = nullptr;
    if (multi) bar = xcd_barrier_post(ctl + CW_BAR + ap0->li * XCD_BAR_WORDS, MISC + 8);
    const int lo = ap0->ph_lo, hi = ap0->ph_hi;
    const int gw = F.vcu * NWAVES + F.wave, NGW = F.G * NWAVES;

    if (IN(0)) {
        P p; load_p(p, ap0);
        LAS float* scr = (LAS float*)(F.lds + F.wave * 16384);
        { CArgsF* q = ap0; asm volatile("" : "+s"(q)); for (int it = gw; it < CI_TOTAL; it += NGW) cvt_item(q, it, scr, F.lane); }
        for (int it = gw; it < 32 * 33; it += NGW) s5::table_item(p, it / 33, it % 33, scr, F.lane);
        bf16* H0b = (bf16*)(p.ws + WS_R1);
        for (int r = gw; r < MR; r += NGW) {
            const float* src = r < MX ? p.in[I_X] + (size_t)r * D : p.in[I_META] + (size_t)(r - MX) * D;
#pragma unroll
            for (int j = 0; j < 4; ++j) { const f32x4 v = *(const f32x4*)(src + j * 256 + F.lane * 4);
                *(unsigned long long*)(H0b + (size_t)r * D + j * 256 + F.lane * 4) = (unsigned long long)pk2(v[0], v[1]) | ((unsigned long long)pk2(v[2], v[3]) << 32); }
        }
    }
    SEAM(0);
    if (IN(1)) {
        P p; load_p(p, ap0);
        pg8::DenseOrder S; S.init(p.ws + WS_R1, p.ws + WB_WIN0, MX, NZ0, D, F.G, (int)blockIdx.x);
        FEpiZ0 E{(bf16*)(p.ws + WS_Z)};
        pg8::gemm_phase<FEpiZ0, pg8::DenseOrder, true>(F.lds, D, S, E);
        meta_gemm(F, p, (const bf16*)(p.ws + WS_R1) + (size_t)MX * D, D, (const bf16*)(p.ws + WB_WIN0), NZ0, D, EZ0{});
    }
    SEAM(1);

    if (IN(2)) { P p; load_p(p, ap0); s5::s5_phase(F, p, F.lds); }
    if (IN(3)) { P p; load_p(p, ap0); att::attn_phase(F, p, F.lds); }
    SEAM(3);
    if (IN(4)) {
        P p; load_p(p, ap0);
        pg8::DenseOrder S; S.init(p.ws + WS_YP, p.ws + WB_WGLU, MX, 512, 512, F.G, (int)blockIdx.x);
        FEpiGLU E{(const bf16*)(p.ws + WS_YP), (bf16*)(p.ws + WS_YM), p.in[I_BGLU]};
        pg8::gemm_phase<FEpiGLU, pg8::DenseOrder, true>(F.lds, 512, S, E);
        meta_gemm(F, p, (const bf16*)(p.ws + WS_YP) + (size_t)MX * 512, 512, (const bf16*)(p.ws + WB_WGLU), 512, 512, EGLU{});
    }
    SEAM(4);
    if (IN(5)) {
        P p; load_p(p, ap0);
        pg8::DenseOrder S; S.init(p.ws + WS_YM, p.ws + WB_WOUT0, MX, D, D, F.G, (int)blockIdx.x);
        FEpiOut0 E{p.in[I_X], (bf16*)(p.ws + WS_R1)};
        pg8::gemm_phase<FEpiOut0, pg8::DenseOrder, true>(F.lds, D, S, E);
        meta_gemm(F, p, (const bf16*)(p.ws + WS_YM) + (size_t)MX * D, D, (const bf16*)(p.ws + WB_WOUT0), D, D, EOUT0{});
    }
    SEAM(5);
    if (IN(6)) { P p; load_p(p, ap0); router_phase<0>(F, p, gw, NGW); }
    SEAM(6);
    moe_gemm_phases<0>(F, ap0, ctl, MISC, bar, lo, hi);
    if (IN(9)) { P p; load_p(p, ap0); combine_phase<0>(F, p, gw, NGW); }
    SEAM(9);
    if (IN(10)) {
        P p; load_p(p, ap0);
        pg8::DenseOrder S; S.init(p.ws + WS_HB, p.ws + WB_WIN1, MX, NZ1, D, F.G, (int)blockIdx.x);
        FEpiZ1 E{(bf16*)(p.ws + WS_Z)};
        pg8::gemm_phase<FEpiZ1, pg8::DenseOrder, true>(F.lds, D, S, E);
        meta_gemm(F, p, (const bf16*)(p.ws + WS_HB) + (size_t)MX * D, D, (const bf16*)(p.ws + WB_WIN1), NZ1, D, EZ1{});
    }
    SEAM(10);
    if (IN(11)) { P p; load_p(p, ap0); lru::conv_phase(F, p); }
    SEAM(11);
    if (IN(12)) { P p; load_p(p, ap0); lru::scan_phase(F, p); }
    SEAM(12);
    if (IN(13)) {
        P p; load_p(p, ap0);
        pg8::DenseOrder S; S.init(p.ws + WS_YM, p.ws + WB_WOUT1, MX, D, DRNN, F.G, (int)blockIdx.x);
        FEpiOut1 E{(const bf16*)(p.ws + WS_HB), (bf16*)(p.ws + WS_R1)};
        pg8::gemm_phase<FEpiOut1, pg8::DenseOrder, true>(F.lds, DRNN, S, E);
        meta_gemm(F, p, (const bf16*)(p.ws + WS_YM) + (size_t)MX * DRNN, DRNN, (const bf16*)(p.ws + WB_WOUT1), D, DRNN, EOUT1{});
    }
    SEAM(13);
    if (IN(14)) { P p; load_p(p, ap0); router_phase<1>(F, p, gw, NGW); }
    SEAM(14);
    moe_gemm_phases<1>(F, ap0, ctl, MISC, bar, lo, hi);
    if (IN(17)) { P p; load_p(p, ap0); combine_phase<1>(F, p, gw, NGW); }

}

static int g_grid = 0;
static void launch_mk(const P& p, int lo, int hi, int li, hipStream_t stream) {
    Args a{}; a.p = p; a.ph_lo = lo; a.ph_hi = hi; a.li = li; a.pad = 0;
    hipLaunchKernelGGL(mk, dim3(g_grid), dim3(NWAVES * 64), LDS_BYTES, stream, a);
}
extern "C" void kernel_launch(void* const* d_in, const int* in_sizes, int n_in, void* d_out, int out_size, void* d_ws, size_t ws_size, hipStream_t stream) {
    if (n_in != 50 || ws_size < WS_END) { fprintf(stderr, "kernel_launch: unexpected n_in %d or ws %zu\n", n_in, ws_size); return; }
    if (g_grid == 0) {
        int dev = 0, cus = 0, per_cu = 0;
        (void)hipGetDevice(&dev); (void)hipDeviceGetAttribute(&cus, hipDeviceAttributeMultiprocessorCount, dev);
        if (hipFuncSetAttribute((const void*)mk, hipFuncAttributeMaxDynamicSharedMemorySize, LDS_BYTES) != hipSuccess) { fprintf(stderr, "hipFuncSetAttribute failed\n"); g_grid = -1; return; }
        if (hipOccupancyMaxActiveBlocksPerMultiprocessor(&per_cu, (const void*)mk, NWAVES * 64, LDS_BYTES) != hipSuccess || per_cu < 1) { fprintf(stderr, "occupancy query: %d\n", per_cu); }
        (void)hipGetLastError();
        g_grid = cus > 0 ? cus : 256;
    }
    if (g_grid < 0) return;
    P p{};
    for (int i = 0; i < 50; ++i) p.in[i] = (const float*)d_in[i];
    p.out = (float*)d_out; p.ws = (unsigned char*)d_ws;
    (void)hipMemsetAsync((char*)d_ws + WS_CTL, 0, 1 * MiB, stream);
    launch_mk(p, 0, 18, 0, stream);
}
```

```cpp
#include <hip/hip_runtime.h>
#include <cstdint>
#include <cstdio>
#include <cmath>

constexpr int D = 1024, NB = 8, SEQ = 2048, NMETA = 16;
constexpr int MX = NB * SEQ;
constexpr int MR = MX + NMETA;
constexpr int MA = MX + 256;
constexpr int NZ0 = 2048, NZ1 = 2560, DRNN = 1280;
constexpr float ALPHA = 1.4142135623730951f;
constexpr float LN_EPS = 1e-5f;
constexpr float QSCALE = 0.125f * 1.4426950408889634f;
constexpr float LAM_INIT = 0.2f;
constexpr int NE = 32;
constexpr int LIST_CAP = MR;
constexpr int SLOT_CAP = 40960;

typedef unsigned short bf16;
__device__ __forceinline__ float bf2f(bf16 v) { return __uint_as_float(((unsigned)v) << 16); }
__device__ __forceinline__ bf16 f2bf(float f) { unsigned u = __float_as_uint(f); return (bf16)((u + 0x7fffu + ((u >> 16) & 1u)) >> 16); }

constexpr size_t MiB = 1u << 20;
constexpr size_t WS_CTL = 0;
constexpr size_t WS_ROUTE = 1 * MiB;
constexpr size_t WS_GATE = WS_ROUTE + 2 * MiB + 512 * 1024;
constexpr size_t WS_EBASE = WS_ROUTE + 3 * MiB - 1024;
constexpr size_t WS_WB = 4 * MiB;
constexpr size_t WS_MOE0 = 28 * MiB;
constexpr size_t WS_MOE1 = 124 * MiB;
constexpr size_t WS_R1 = 220 * MiB;
constexpr size_t WS_Z = 253 * MiB;
constexpr size_t WS_YP = 335 * MiB;
constexpr size_t WS_YM = 352 * MiB;
constexpr size_t WS_HB = 393 * MiB;
constexpr size_t WS_END = 426 * MiB;
constexpr int CW_CNT0 = 32768, CW_CNT1 = 32768 + 2048;
#define CNT_IDX(e) ((e) * 64)

struct P {
    const float* in[50];
    float* out;
    unsigned char* ws;
};
enum { I_X = 0, I_META, I_L0LN1G, I_L0LN1B, I_L0WIN, I_LRE, I_LIM, I_LOGDT, I_BRE, I_BIM, I_CRE, I_CIM, I_S5D, I_WGLU, I_BGLU,
       I_LQ1, I_LK1, I_LQ2, I_LK2, I_SUBLN, I_L0WOUT, I_L0LN2G, I_L0LN2B, I_M0WC, I_M0BC, I_M0WF, I_M0BF, I_M0WG, I_M0WU, I_M0WD,
       I_L1LN1G, I_L1LN1B, I_L1WIN, I_CONVW, I_CONVB, I_WA, I_BA, I_WX, I_BX, I_LAM, I_L1WOUT, I_L1LN2G, I_L1LN2B,
       I_M1WC, I_M1BC, I_M1WF, I_M1BF, I_M1WG, I_M1WU, I_M1WD };

__device__ __forceinline__ float gelu_tanh(float x) {
    const float c = 0.7978845608028654f;
    float u = c * (x + 0.044715f * x * x * x);
    return 0.5f * x * (1.f + tanhf(u));
}
__device__ __forceinline__ float sigmoidf_(float x) { return 1.f / (1.f + expf(-x)); }
__device__ __forceinline__ float wave_sum(float v) {
#pragma unroll
    for (int o = 1; o < 64; o <<= 1) v += __shfl_xor(v, o);
    return v;
}
__device__ __forceinline__ float wave_max(float v) {
#pragma unroll
    for (int o = 1; o < 64; o <<= 1) v = fmaxf(v, __shfl_xor(v, o));
    return v;
}

__global__ void n_h0(P p) {
    bf16* H0b = (bf16*)(p.ws + WS_R1);
    size_t i = (size_t)blockIdx.x * blockDim.x + threadIdx.x;
    if (i >= (size_t)MR * D) return;
    size_t r = i / D, c = i % D;
    float v = r < MX ? p.in[I_X][i] : p.in[I_META][(r - MX) * D + c];
    H0b[i] = f2bf(v);
}

template <class E, bool DUAL>
__global__ void __launch_bounds__(256) n_gemm(P p, E e) {
    __shared__ float As[16][65];
    __shared__ float Ws[16][65];
    __shared__ float Ws2[DUAL ? 16 : 1][65];
    int M, N, K, lda, ldw; const bf16* A; const float* W; const float* W2;
    if (!e.setup(p, blockIdx.z, M, N, K, A, lda, W, W2, ldw)) return;
    const int m0 = blockIdx.y * 64, n0 = blockIdx.x * 64;
    if (m0 >= M || n0 >= N) return;
    const int tx = threadIdx.x & 15, ty = threadIdx.x >> 4;
    float acc[4][4] = {}, acc2[4][4] = {};
    for (int k0 = 0; k0 < K; k0 += 16) {
        for (int i = threadIdx.x; i < 64 * 16; i += 256) {
            int mm = i >> 4, kk = i & 15; int m = m0 + mm;
            float v = 0.f;
            if (m < M) { long ar = e.arow(p, blockIdx.z, m); v = bf2f(A[(size_t)ar * lda + k0 + kk]); }
            As[kk][mm] = v;
        }
        for (int i = threadIdx.x; i < 64 * 16; i += 256) {
            int kk = i >> 6, nn = i & 63;
            Ws[kk][nn] = W[(size_t)(k0 + kk) * ldw + n0 + nn];
            if (DUAL) Ws2[kk][nn] = W2[(size_t)(k0 + kk) * ldw + n0 + nn];
        }
        __syncthreads();
#pragma unroll
        for (int kk = 0; kk < 16; ++kk) {
            float a[4], b[4], b2[4];
#pragma unroll
            for (int i = 0; i < 4; ++i) { a[i] = As[kk][ty * 4 + i]; b[i] = Ws[kk][tx * 4 + i]; b2[i] = DUAL ? Ws2[kk][tx * 4 + i] : 0.f; }
#pragma unroll
            for (int i = 0; i < 4; ++i)
#pragma unroll
                for (int j = 0; j < 4; ++j) { acc[i][j] += a[i] * b[j]; if (DUAL) acc2[i][j] += a[i] * b2[j]; }
        }
        __syncthreads();
    }
#pragma unroll
    for (int i = 0; i < 4; ++i)
#pragma unroll
        for (int j = 0; j < 4; ++j) {
            int m = m0 + ty * 4 + i, n = n0 + tx * 4 + j;
            if (m < M) e.store(p, blockIdx.z, m, n, acc[i][j], acc2[i][j]);
        }
}

struct EZ0 {
    __device__ bool setup(const P& p, int z, int& M, int& N, int& K, const bf16*& A, int& lda, const float*& W, const float*& W2, int& ldw) const {
        M = MR; N = NZ0; K = D; A = (const bf16*)(p.ws + WS_R1); lda = D; W = p.in[I_L0WIN]; W2 = nullptr; ldw = NZ0; return true; }
    __device__ long arow(const P&, int, int m) const { return m; }
    __device__ void store(const P& p, int, int m, int n, float v, float) const {
        bf16* Z = (bf16*)(p.ws + WS_Z); if (n >= 512 && n < 1024) v *= QSCALE; Z[(size_t)m * NZ0 + n] = f2bf(v); }
};
struct EGLU {
    __device__ bool setup(const P& p, int z, int& M, int& N, int& K, const bf16*& A, int& lda, const float*& W, const float*& W2, int& ldw) const {
        M = MR; N = 512; K = 512; A = (const bf16*)(p.ws + WS_YP); lda = 512; W = p.in[I_WGLU]; W2 = nullptr; ldw = 512; return true; }
    __device__ long arow(const P&, int, int m) const { return m; }
    __device__ void store(const P& p, int, int m, int n, float v, float) const {
        const bf16* YP = (const bf16*)(p.ws + WS_YP); bf16* YM = (bf16*)(p.ws + WS_YM);
        float y = bf2f(YP[(size_t)m * 512 + n]); YM[(size_t)m * D + n] = f2bf(y * sigmoidf_(v + p.in[I_BGLU][n])); }
};
struct EOUT0 {
    __device__ bool setup(const P& p, int z, int& M, int& N, int& K, const bf16*& A, int& lda, const float*& W, const float*& W2, int& ldw) const {
        M = MR; N = D; K = D; A = (const bf16*)(p.ws + WS_YM); lda = D; W = p.in[I_L0WOUT]; W2 = nullptr; ldw = D; return true; }
    __device__ long arow(const P&, int, int m) const { return m; }
    __device__ void store(const P& p, int, int m, int n, float v, float) const {
        bf16* R1 = (bf16*)(p.ws + WS_R1);
        float h0 = m < MX ? p.in[I_X][(size_t)m * D + n] : p.in[I_META][(size_t)(m - MX) * D + n];
        R1[(size_t)m * D + n] = f2bf(ALPHA * h0 + v); }
};
template <int L> struct EMOE1 {
    __device__ bool setup(const P& p, int z, int& M, int& N, int& K, const bf16*& A, int& lda, const float*& W, const float*& W2, int& ldw) const {
        const int* cnt = (const int*)(p.ws + WS_CTL) + (L ? CW_CNT1 : CW_CNT0);
        M = cnt[CNT_IDX(z)]; N = 512; K = D; A = (const bf16*)(p.ws + WS_HB); lda = D;
        W = p.in[L ? I_M1WG : I_M0WG] + (size_t)z * D * 512; W2 = p.in[L ? I_M1WU : I_M0WU] + (size_t)z * D * 512; ldw = 512; return M > 0; }
    __device__ long arow(const P& p, int z, int m) const { const int* list = (const int*)(p.ws + WS_ROUTE); return list[(size_t)z * LIST_CAP + m] >> 1; }
    __device__ void store(const P& p, int z, int m, int n, float g, float u) const {
        const int* ebase = (const int*)(p.ws + WS_EBASE);
        bf16* HID = (bf16*)(p.ws + WS_YM);
        float s = g / (1.f + expf(-g));
        HID[(size_t)(ebase[z] + m) * 512 + n] = f2bf(s * u); }
};
template <int L> struct EMOE2 {
    __device__ bool setup(const P& p, int z, int& M, int& N, int& K, const bf16*& A, int& lda, const float*& W, const float*& W2, int& ldw) const {
        const int* cnt = (const int*)(p.ws + WS_CTL) + (L ? CW_CNT1 : CW_CNT0);
        M = cnt[CNT_IDX(z)]; N = D; K = 512; A = (const bf16*)(p.ws + WS_YM); lda = 512;
        W = p.in[L ? I_M1WD : I_M0WD] + (size_t)z * 512 * D; W2 = nullptr; ldw = D; return M > 0; }
    __device__ long arow(const P& p, int z, int m) const { const int* ebase = (const int*)(p.ws + WS_EBASE); return ebase[z] + m; }
    __device__ void store(const P& p, int z, int m, int n, float v, float) const {
        const int* list = (const int*)(p.ws + WS_ROUTE); const float* gate = (const float*)(p.ws + WS_GATE);
        int asg = list[(size_t)z * LIST_CAP + m];
        bf16* Y2 = (bf16*)(p.ws + WS_Z);
        Y2[(size_t)asg * D + n] = f2bf(v * gate[asg]); }
};
struct EZ1 {
    __device__ bool setup(const P& p, int z, int& M, int& N, int& K, const bf16*& A, int& lda, const float*& W, const float*& W2, int& ldw) const {
        M = MR; N = NZ1; K = D; A = (const bf16*)(p.ws + WS_HB); lda = D; W = p.in[I_L1WIN]; W2 = nullptr; ldw = NZ1; return true; }
    __device__ long arow(const P&, int, int m) const { return m; }
    __device__ void store(const P& p, int, int m, int n, float v, float) const {
        bf16* Z = (bf16*)(p.ws + WS_Z);
        if (n < DRNN) Z[(size_t)m * NZ1 + n] = f2bf(gelu_tanh(v)); else Z[(size_t)m * NZ1 + n] = f2bf(v); }
};
struct EOUT1 {
    __device__ bool setup(const P& p, int z, int& M, int& N, int& K, const bf16*& A, int& lda, const float*& W, const float*& W2, int& ldw) const {
        M = MR; N = D; K = DRNN; A = (const bf16*)(p.ws + WS_YM); lda = DRNN; W = p.in[I_L1WOUT]; W2 = nullptr; ldw = D; return true; }
    __device__ long arow(const P&, int, int m) const { return m; }
    __device__ void store(const P& p, int, int m, int n, float v, float) const {
        bf16* R1 = (bf16*)(p.ws + WS_R1); const bf16* Hb = (const bf16*)(p.ws + WS_HB);
        R1[(size_t)m * D + n] = f2bf(ALPHA * bf2f(Hb[(size_t)m * D + n]) + v); }
};

__global__ void __launch_bounds__(64) n_s5(P p) {
    const int b = blockIdx.x >> 5, g = blockIdx.x & 31, lane = threadIdx.x;
    const bf16* Z = (const bf16*)(p.ws + WS_Z); bf16* YP = (bf16*)(p.ws + WS_YP);
    __shared__ float su[16], shr[64], shi[64], scre[16][64], scim[16][64];
    for (int i = lane; i < 1024; i += 64) { scre[i >> 6][i & 63] = p.in[I_CRE][(size_t)g * 1024 + i]; scim[i >> 6][i & 63] = p.in[I_CIM][(size_t)g * 1024 + i]; }
    const float dt = expf(p.in[I_LOGDT][g]);
    const float lr = fminf(p.in[I_LRE][g * 64 + lane], -1e-4f), li = p.in[I_LIM][g * 64 + lane];
    const float mag = expf(lr * dt), ar = mag * cosf(li * dt), ai = mag * sinf(li * dt);
    const float den = lr * lr + li * li, nr = ar - 1.f, ni = ai;
    const float fr = (nr * lr + ni * li) / den, fi = (ni * lr - nr * li) / den;
    float bbr[16], bbi[16];
#pragma unroll
    for (int h = 0; h < 16; ++h) { float br = p.in[I_BRE][((size_t)g * 64 + lane) * 16 + h], bi = p.in[I_BIM][((size_t)g * 64 + lane) * 16 + h];
        bbr[h] = fr * br - fi * bi; bbi[h] = fr * bi + fi * br; }
    float hr = 0.f, hi = 0.f;
    __syncthreads();
    for (int s = 0; s < NMETA + SEQ; ++s) {
        const size_t row = s < NMETA ? (size_t)(MX + s) : (size_t)b * SEQ + (s - NMETA);
        if (lane < 16) su[lane] = bf2f(Z[row * NZ0 + g * 16 + lane]);
        __syncthreads();
        float bur = 0.f, bui = 0.f;
#pragma unroll
        for (int h = 0; h < 16; ++h) { bur += su[h] * bbr[h]; bui += su[h] * bbi[h]; }
        const float nhr = ar * hr - ai * hi + bur, nhi = ar * hi + ai * hr + bui;
        hr = nhr; hi = nhi; shr[lane] = hr; shi[lane] = hi;
        __syncthreads();
        const int h = lane >> 2, q = lane & 3;
        float y = 0.f;
        for (int pp = q * 16; pp < q * 16 + 16; ++pp) y += shr[pp] * scre[h][pp] - shi[pp] * scim[h][pp];
        y += __shfl_xor(y, 1); y += __shfl_xor(y, 2);
        if (q == 0 && (s >= NMETA || b == 0)) {
            y += p.in[I_S5D][g * 16 + h] * su[h];
            YP[row * 512 + g * 16 + h] = f2bf(gelu_tanh(y));
        }
        __syncthreads();
    }
}

__global__ void __launch_bounds__(256) n_attn(P p) {
    const int r = blockIdx.x, h = threadIdx.x >> 6, lane = threadIdx.x & 63;
    const bf16* Z = (const bf16*)(p.ws + WS_Z); bf16* YM = (bf16*)(p.ws + WS_YM);
    __shared__ float sc[4][NMETA + SEQ];
    __shared__ float sq[4][64];
    int nk, b = 0;
    if (r >= MX) nk = NMETA; else { b = r >> 11; int t = r & 2047; nk = NMETA + 64 * (t / 64 + 1); }
    const float l1 = wave_sum(p.in[I_LQ1][lane] * p.in[I_LK1][lane]);
    const float l2 = wave_sum(p.in[I_LQ2][lane] * p.in[I_LK2][lane]);
    const float lam = expf(l1) - expf(l2) + LAM_INIT;
    float o[2][2];
    for (int c = 0; c < 2; ++c) {
        sq[h][lane] = bf2f(Z[(size_t)r * NZ0 + 512 + h * 128 + c * 64 + lane]);
        __syncthreads();
        float mx = -1e30f;
        for (int kk = lane; kk < nk; kk += 64) {
            const size_t kr = kk < NMETA ? (size_t)(MX + kk) : (size_t)b * SEQ + (kk - NMETA);
            const bf16* kp = Z + kr * NZ0 + 1024 + h * 128 + c * 64;
            float s = 0.f;
            for (int d = 0; d < 64; ++d) s += sq[h][d] * bf2f(kp[d]);
            sc[h][kk] = s; mx = fmaxf(mx, s);
        }
        mx = wave_max(mx);
        float l = 0.f;
        for (int kk = lane; kk < nk; kk += 64) { float e = exp2f(sc[h][kk] - mx); sc[h][kk] = e; l += e; }
        l = wave_sum(l);
        __syncthreads();
        float a0 = 0.f, a1 = 0.f;
        for (int kk = 0; kk < nk; ++kk) {
            const size_t kr = kk < NMETA ? (size_t)(MX + kk) : (size_t)b * SEQ + (kk - NMETA);
            const bf16* vp = Z + kr * NZ0 + 1536 + h * 128 + lane * 2;
            const float pw = sc[h][kk];
            a0 += pw * bf2f(vp[0]); a1 += pw * bf2f(vp[1]);
        }
        o[c][0] = a0 / l; o[c][1] = a1 / l;
        __syncthreads();
    }
    float v0 = o[0][0] - lam * o[1][0], v1 = o[0][1] - lam * o[1][1];
    float ss = wave_sum(v0 * v0 + v1 * v1);
    float rs = 1.f / sqrtf(ss / 128.f + LN_EPS);
    v0 = v0 * rs * p.in[I_SUBLN][lane * 2] * (1.f - LAM_INIT); v1 = v1 * rs * p.in[I_SUBLN][lane * 2 + 1] * (1.f - LAM_INIT);
    YM[(size_t)r * D + 512 + h * 128 + lane * 2] = f2bf(v0);
    YM[(size_t)r * D + 512 + h * 128 + lane * 2 + 1] = f2bf(v1);
}

template <int L> __global__ void __launch_bounds__(256) n_router(P p) {
    const int wave = threadIdx.x >> 6, lane = threadIdx.x & 63;
    const int r = blockIdx.x * 4 + wave; if (r >= MR) return;
    const bf16* R1 = (const bf16*)(p.ws + WS_R1); bf16* Hb = (bf16*)(p.ws + WS_HB);
    const float* g = p.in[L ? I_L1LN1G : I_L0LN1G]; const float* bb = p.in[L ? I_L1LN1B : I_L0LN1B];
    const float* wc = p.in[L ? I_M1WC : I_M0WC]; const float* bc = p.in[L ? I_M1BC : I_M0BC];
    const float* wf = p.in[L ? I_M1WF : I_M0WF]; const float* bfi = p.in[L ? I_M1BF : I_M0BF];
    float v[16]; float s = 0.f;
#pragma unroll
    for (int j = 0; j < 16; ++j) { v[j] = bf2f(R1[(size_t)r * D + j * 64 + lane]); s += v[j]; }
    const float mean = wave_sum(s) / D; float q = 0.f;
#pragma unroll
    for (int j = 0; j < 16; ++j) { v[j] -= mean; q += v[j] * v[j]; }
    const float rstd = 1.f / sqrtf(wave_sum(q) / D + LN_EPS);
#pragma unroll
    for (int j = 0; j < 16; ++j) { int c = j * 64 + lane; bf16 hb = f2bf(v[j] * rstd * g[c] + bb[c]); v[j] = bf2f(hb); Hb[(size_t)r * D + c] = hb; }
    float lc[4];
#pragma unroll
    for (int c4 = 0; c4 < 4; ++c4) { float a = 0.f;
#pragma unroll
        for (int j = 0; j < 16; ++j) a += v[j] * wc[(size_t)(j * 64 + lane) * 4 + c4];
        lc[c4] = wave_sum(a) + bc[c4]; }
    int grp = 0; float mxc = lc[0];
#pragma unroll
    for (int c4 = 1; c4 < 4; ++c4) if (lc[c4] > mxc) { mxc = lc[c4]; grp = c4; }
    float se = 0.f;
#pragma unroll
    for (int c4 = 0; c4 < 4; ++c4) se += expf(lc[c4] - mxc);
    const float pgrp = 1.f / se;
    float lf[8];
#pragma unroll
    for (int e8 = 0; e8 < 8; ++e8) { float a = 0.f;
#pragma unroll
        for (int j = 0; j < 16; ++j) a += v[j] * wf[((size_t)grp * D + j * 64 + lane) * 8 + e8];
        lf[e8] = wave_sum(a) + bfi[grp * 8 + e8]; }
    int i0 = 0; float v0 = lf[0];
#pragma unroll
    for (int e8 = 1; e8 < 8; ++e8) if (lf[e8] > v0) { v0 = lf[e8]; i0 = e8; }
    int i1 = -1; float v1 = -1e30f;
#pragma unroll
    for (int e8 = 0; e8 < 8; ++e8) if (e8 != i0 && lf[e8] > v1) { v1 = lf[e8]; i1 = e8; }
    const float e1 = expf(v1 - v0); const float g0 = pgrp / (1.f + e1), g1 = pgrp * e1 / (1.f + e1);
    if (lane == 0) {
        int* cnt = (int*)(p.ws + WS_CTL) + (L ? CW_CNT1 : CW_CNT0);
        int* list = (int*)(p.ws + WS_ROUTE); float* gate = (float*)(p.ws + WS_GATE);
        const int ea = grp * 8 + i0, eb = grp * 8 + i1;
        int pa = atomicAdd(&cnt[CNT_IDX(ea)], 1); list[(size_t)ea * LIST_CAP + pa] = r * 2; gate[r * 2] = g0;
        int pb = atomicAdd(&cnt[CNT_IDX(eb)], 1); list[(size_t)eb * LIST_CAP + pb] = r * 2 + 1; gate[r * 2 + 1] = g1;
    }
}
template <int L> __global__ void n_ebase(P p) {
    if (threadIdx.x == 0) { const int* cnt = (const int*)(p.ws + WS_CTL) + (L ? CW_CNT1 : CW_CNT0); int* ebase = (int*)(p.ws + WS_EBASE);
        int acc = 0; for (int e = 0; e < NE; ++e) { ebase[e] = acc; acc += (cnt[CNT_IDX(e)] + 255) / 256 * 256; } }
}
template <int L> __global__ void __launch_bounds__(256) n_combine(P p) {
    const int wave = threadIdx.x >> 6, lane = threadIdx.x & 63;
    const int r = blockIdx.x * 4 + wave; if (r >= MR) return;
    bf16* Hb = (bf16*)(p.ws + WS_HB); const bf16* Y2 = (const bf16*)(p.ws + WS_Z);
    const float* g = p.in[L ? I_L1LN2G : I_L0LN2G]; const float* bb = p.in[L ? I_L1LN2B : I_L0LN2B];
    float v[16]; float s = 0.f;
#pragma unroll
    for (int j = 0; j < 16; ++j) { int c = j * 64 + lane; v[j] = ALPHA * bf2f(Hb[(size_t)r * D + c]) + bf2f(Y2[(size_t)(2 * r) * D + c]) + bf2f(Y2[(size_t)(2 * r + 1) * D + c]); s += v[j]; }
    const float mean = wave_sum(s) / D; float q = 0.f;
#pragma unroll
    for (int j = 0; j < 16; ++j) { v[j] -= mean; q += v[j] * v[j]; }
    const float rstd = 1.f / sqrtf(wave_sum(q) / D + LN_EPS);
#pragma unroll
    for (int j = 0; j < 16; ++j) { int c = j * 64 + lane; float o = v[j] * rstd * g[c] + bb[c];
        if (L == 0) Hb[(size_t)r * D + c] = f2bf(o); else if (r < MX) p.out[(size_t)r * D + c] = o; }
}
__global__ void __launch_bounds__(128) n_lru(P p) {
    const int b = blockIdx.x / 10, n = blockIdx.x % 10, c = threadIdx.x, ch = n * 128 + c;
    const bf16* Z = (const bf16*)(p.ws + WS_Z); bf16* Y1 = (bf16*)(p.ws + WS_YM);
    __shared__ float xc[128];
    const float cw0 = p.in[I_CONVW][ch], cw1 = p.in[I_CONVW][DRNN + ch], cw2 = p.in[I_CONVW][2 * DRNN + ch], cw3 = p.in[I_CONVW][3 * DRNN + ch], cb = p.in[I_CONVB][ch];
    const float* wa = p.in[I_WA] + (size_t)n * 128 * 128; const float* wx = p.in[I_WX] + (size_t)n * 128 * 128;
    const float ba = p.in[I_BA][ch], bx = p.in[I_BX][ch];
    const float lam = p.in[I_LAM][ch]; const float sp = log1pf(expf(-lam));
    float r0 = 0.f, r1 = 0.f, r2 = 0.f, hstate = 0.f;
    for (int s = 0; s < NMETA + SEQ; ++s) {
        const size_t row = s < NMETA ? (size_t)(MX + s) : (size_t)b * SEQ + (s - NMETA);
        const float r3 = bf2f(Z[row * NZ1 + DRNN + ch]);
        const float x = r0 * cw0 + r1 * cw1 + r2 * cw2 + r3 * cw3 + cb;
        r0 = r1; r1 = r2; r2 = r3;
        xc[c] = x;
        __syncthreads();
        float aa = 0.f, ax = 0.f;
        for (int d = 0; d < 128; ++d) { const float xv = xc[d]; aa += xv * wa[d * 128 + c]; ax += xv * wx[d * 128 + c]; }
        const float rg = sigmoidf_(aa + ba), ig = sigmoidf_(ax + bx);
        const float log_a = -8.f * rg * sp; const float a = expf(log_a);
        const float bt = sqrtf(-expm1f(2.f * log_a)) * (ig * x);
        hstate = a * hstate + bt;
        if (s >= NMETA || b == 0) Y1[row * DRNN + ch] = f2bf(bf2f(Z[row * NZ1 + ch]) * hstate);
        __syncthreads();
    }
}

namespace pg8 {
#define PG8_LAS __attribute__((address_space(3)))
typedef unsigned short bf16_t;
typedef short bf16x8 __attribute__((ext_vector_type(8)));
typedef float f32x4 __attribute__((ext_vector_type(4)));
typedef float f32x2 __attribute__((ext_vector_type(2)));
typedef unsigned u32x4 __attribute__((ext_vector_type(4)));
typedef unsigned u32x2 __attribute__((ext_vector_type(2)));
constexpr int BM = 256, BK = 64, HALF = 128, HTB = HALF * BK * 2  , STAGE_BYTES = 8 * HTB, NXCD = 8, WGM = 8;

__host__ __device__ __forceinline__ int lds_byte(int r, int c) { const int st = (r >> 4) * 2 + (c >> 5), rr = r & 15, cc = c & 31, ob = rr * 64 + cc * 2; return st * 1024 + (ob ^ (((ob >> 9) & 1) << 5)); }
__host__ __device__ __forceinline__ void stage_rc(int b, int& R, int& C) { const int st = b / 1024, sb = b % 1024, swz = sb ^ (((sb >> 9) & 1) << 5); R = (st >> 1) * 16 + swz / 64; C = (st & 1) * 32 + (swz % 64) / 2; }
__host__ __device__ __forceinline__ int perm32(int rho) { const int n = rho >> 4, i = rho & 15; return 8 * (i >> 2) + 4 * n + (i & 3); }

struct Unit { const char* a; const char* b; int pm, pn, ex, nrow; };

struct DenseOrder {
    static constexpr bool GATHER = false;
    const char* A; const char* Bt; int K; int nM, nN, nwg, G, c;
    __device__ void init(const void* A_, const void* Bt_, int M, int N, int K_, int G_, int c_) { A = (const char*)A_; Bt = (const char*)Bt_; K = K_; nM = M / BM; nN = N / BM; nwg = nM * nN; G = G_; c = c_; }
    __device__ bool next(int i, Unit& u) const {
        const long L = (long)i * G + c; if (L >= nwg) return false;
        int wgid = (int)L; { const int q = nwg / NXCD, r = nwg % NXCD, xcd = wgid % NXCD, off = wgid / NXCD; wgid = (xcd < r ? xcd * (q + 1) : r * (q + 1) + (xcd - r) * q) + off; }
        const int nig = WGM * nN, gid = wgid / nig, fm = gid * WGM, gsz = (nM - fm) < WGM ? (nM - fm) : WGM;
        u.pm = fm + ((wgid % nig) % gsz); u.pn = (wgid % nig) / gsz; u.ex = 0; u.nrow = BM;
        u.a = A + (size_t)u.pm * BM * K * 2; u.b = Bt + (size_t)u.pn * BM * K * 2; return true;
    }
    __device__ __forceinline__ void voffs(const Unit&, int, unsigned (&)[2], unsigned (&)[2]) const {}
};

__device__ __forceinline__ unsigned cvt_pk_bf16(float lo, float hi) { unsigned r; asm volatile("v_cvt_pk_bf16_f32 %0, %1, %2" : "=v"(r) : "v"(lo), "v"(hi)); return r; }

template <class Epi, class Sched, bool ALIGN_EPI>
__device__ __forceinline__ void gemm_phase(PG8_LAS unsigned char* lds, const int K, const Sched& S, const Epi& E) {
    constexpr bool GATHER = Sched::GATHER;
    int tid_ = threadIdx.x; asm volatile("" : "+v"(tid_));
    const int tid = tid_, wid = __builtin_amdgcn_readfirstlane(tid >> 6), lane = tid & 63, wr = wid >> 2, wc = wid & 3, fr = lane & 15, fq = lane >> 4;
    const int nt = K / BK;
    unsigned voffA[2], voffA1[2], voffB[2];
#pragma unroll
    for (int i = 0; i < 2; ++i) { int R, C; stage_rc(tid * 16 + i * 8192, R, C); const int Rb = Epi::PERM ? ((R & ~31) + perm32(R & 31)) : R;
        voffA[i] = (unsigned)(R * K + C) * 2u; voffA1[i] = voffA[i]; voffB[i] = (unsigned)(Rb * K + C) * 2u; }
    const size_t kstep = (size_t)(BK * 2);
    const size_t hstep = (size_t)HALF * K * 2;
    const size_t hstepA = GATHER ? 0 : hstep;
    const unsigned ldsw = (unsigned)wid * 1024u;
    const int aoff = lds_byte(wr * 64 + fr, fq * 8), boff = lds_byte(wc * 32 + fr, fq * 8);
#define PG8_SA(b, h) (((b) * 2 + (h)) * HTB)
#define PG8_SB(b, h) ((4 + (b) * 2 + (h)) * HTB)
#define PG8_STAGE(bufoff, gbase, voff) do { _Pragma("unroll") for (int _i = 0; _i < 2; ++_i) \
        __builtin_amdgcn_global_load_lds((const unsigned*)((const char*)(gbase) + (voff)[_i]), (PG8_LAS unsigned*)(lds + (bufoff) + ldsw + _i * 8192), 16, 0, 0); } while (0)
#define PG8_STAGE_A0(b, gbase) PG8_STAGE(PG8_SA(b, 0), gbase, voffA)
#define PG8_STAGE_A1(b, gbase) PG8_STAGE(PG8_SA(b, 1), (gbase) + hstepA, voffA1)
#define PG8_LDA(dst, b, h) do { _Pragma("unroll") for (int m = 0; m < 4; ++m) _Pragma("unroll") for (int k = 0; k < 2; ++k) dst[m][k] = *(const PG8_LAS bf16x8*)(lds + PG8_SA(b, h) + aoff + m * 2048 + k * 1024); } while (0)
#define PG8_LDB(dst, b, h) do { _Pragma("unroll") for (int n = 0; n < 2; ++n) _Pragma("unroll") for (int k = 0; k < 2; ++k) dst[n][k] = *(const PG8_LAS bf16x8*)(lds + PG8_SB(b, h) + boff + n * 2048 + k * 1024); } while (0)
#define PG8_MMA(ai, bj, At, Bt) do { __builtin_amdgcn_s_setprio(1); _Pragma("unroll") for (int m = 0; m < 4; ++m) _Pragma("unroll") for (int n = 0; n < 2; ++n) _Pragma("unroll") for (int k = 0; k < 2; ++k) \
        acc[ai][bj][m][n] = __builtin_amdgcn_mfma_f32_16x16x32_bf16(Bt[n][k], At[m][k], acc[ai][bj][m][n], 0, 0, 0); __builtin_amdgcn_s_setprio(0); } while (0)
#define PG8_WAIT_V(n) asm volatile("s_waitcnt vmcnt(" #n ")" ::: "memory")
#define PG8_WAIT_L(n) asm volatile("s_waitcnt lgkmcnt(" #n ")" ::: "memory")
#define PG8_BAR __builtin_amdgcn_s_barrier()
#define PG8_SCHED __builtin_amdgcn_sched_barrier(0)
    Unit cur, nxt; int ui = 0;
    if (!S.next(0, cur)) return;
    if (GATHER) S.voffs(cur, tid, voffA, voffA1);
    f32x4 acc[2][2][4][2];
#pragma unroll
    for (int a = 0; a < 2; ++a)
#pragma unroll
        for (int b = 0; b < 2; ++b)
#pragma unroll
            for (int m = 0; m < 4; ++m)
#pragma unroll
                for (int n = 0; n < 2; ++n) acc[a][b][m][n] = (f32x4){0.f, 0.f, 0.f, 0.f};
    bf16x8 At[4][2], B0[2][2], B1[2][2];
    const char* cA = cur.a; const char* cB = cur.b;
    PG8_STAGE(PG8_SB(0, 0), cB, voffB); PG8_STAGE(PG8_SB(0, 1), cB + hstep, voffB); PG8_STAGE_A0(0, cA); PG8_STAGE_A1(0, cA);
    if (wr == 1) PG8_BAR;
    PG8_WAIT_V(2); PG8_BAR;
    PG8_STAGE(PG8_SB(1, 0), cB + kstep, voffB); PG8_STAGE_A0(1, cA + kstep); PG8_STAGE(PG8_SB(1, 1), cB + hstep + kstep, voffB);
    PG8_WAIT_V(6); PG8_BAR;
    for (;;) {
        const bool has_next = S.next(ui + 1, nxt);
        const char* nA = has_next ? nxt.a : cA; const char* nB = has_next ? nxt.b : cB;
        for (int t = 0; t < nt; t += 2) {
            const bool last = (t == nt - 2);
            const char* a1 = cA + (size_t)(t + 1) * kstep;
            const char* a2 = last ? nA : cA + (size_t)(t + 2) * kstep; const char* b2 = last ? nB : cB + (size_t)(t + 2) * kstep;
            const char* a3 = a2 + kstep; const char* b3 = b2 + kstep;
            PG8_LDB(B0, 0, 0); PG8_LDB(B1, 0, 1); PG8_SCHED; PG8_LDA(At, 0, 0); PG8_STAGE_A1(1, a1);
            if (GATHER) { if (last && has_next) S.voffs(nxt, tid, voffA, voffA1); }
            PG8_WAIT_V(8); PG8_WAIT_L(0); PG8_BAR; PG8_MMA(0, 0, At, B0); PG8_MMA(0, 1, At, B1); PG8_BAR; PG8_SCHED;
            PG8_LDA(At, 0, 1); PG8_STAGE(PG8_SB(0, 0), b2, voffB); PG8_STAGE(PG8_SB(0, 1), b2 + hstep, voffB); PG8_STAGE_A0(0, a2);
            PG8_WAIT_V(8); PG8_WAIT_L(0); PG8_BAR; PG8_MMA(1, 0, At, B0); PG8_MMA(1, 1, At, B1); PG8_BAR; PG8_SCHED;
            PG8_LDB(B0, 1, 0); PG8_LDB(B1, 1, 1); PG8_SCHED; PG8_LDA(At, 1, 0); PG8_STAGE_A1(0, a2);
            PG8_WAIT_V(8); PG8_WAIT_L(0); PG8_BAR; PG8_MMA(0, 0, At, B0); PG8_MMA(0, 1, At, B1); PG8_BAR; PG8_SCHED;
            PG8_LDA(At, 1, 1); PG8_STAGE(PG8_SB(1, 0), b3, voffB); PG8_STAGE(PG8_SB(1, 1), b3 + hstep, voffB); PG8_STAGE_A0(1, a3);
            PG8_WAIT_V(8); PG8_WAIT_L(0); PG8_BAR; PG8_MMA(1, 0, At, B0); PG8_MMA(1, 1, At, B1); PG8_BAR; PG8_SCHED;
        }
        if constexpr (ALIGN_EPI) { if (wr == 0) PG8_BAR; }
        E(acc, cur, wr, wc, fr, fq);
        if (!has_next) break;
#pragma unroll
        for (int a = 0; a < 2; ++a)
#pragma unroll
            for (int b = 0; b < 2; ++b)
#pragma unroll
                for (int m = 0; m < 4; ++m)
#pragma unroll
                    for (int n = 0; n < 2; ++n) acc[a][b][m][n] = (f32x4){0.f, 0.f, 0.f, 0.f};
        cur = nxt; cA = nA; cB = nB; ++ui;
        if constexpr (ALIGN_EPI) { if (wr == 1) PG8_BAR; }
    }
    PG8_WAIT_V(0);
    if constexpr (!ALIGN_EPI) { if (wr == 0) PG8_BAR; }
    PG8_BAR;
#undef PG8_SA
#undef PG8_SB
#undef PG8_STAGE
#undef PG8_STAGE_A0
#undef PG8_STAGE_A1
#undef PG8_LDA
#undef PG8_LDB
#undef PG8_MMA
#undef PG8_WAIT_V
#undef PG8_WAIT_L
#undef PG8_BAR
#undef PG8_SCHED
}
}
#define GAS __attribute__((address_space(1)))
#define LAS __attribute__((address_space(3)))
typedef unsigned v4u __attribute__((ext_vector_type(4)));
typedef float f32x4 __attribute__((ext_vector_type(4)));
typedef short bf16x8 __attribute__((ext_vector_type(8)));
#define LDS_WAIT() asm volatile("s_waitcnt lgkmcnt(0)" ::: "memory")
#define VM_WAIT() asm volatile("s_waitcnt vmcnt(0)" ::: "memory")
__device__ __forceinline__ unsigned pk2(float lo, float hi) { return (unsigned)f2bf(lo) | ((unsigned)f2bf(hi) << 16); }

#define XB_TMO      128
#define XB_XCNT(j)  (256  + 64 * (j))
#define XB_XSUB(j)  (1280 + 64 * (j))
#define XB_XGEN(j)  (2304 + 64 * (j))
#define XB_TOP      3328
#define XB_TOPGEN   3392
#define XCD_BAR_WORDS 3456
#define XB_SPIN_CAP (1u << 18)
__device__ __forceinline__ unsigned xb_ld(unsigned* p)              { return __hip_atomic_load(p, __ATOMIC_RELAXED, __HIP_MEMORY_SCOPE_AGENT); }
__device__ __forceinline__ unsigned xb_add(unsigned* p, unsigned v) { return __hip_atomic_fetch_add(p, v, __ATOMIC_RELAXED, __HIP_MEMORY_SCOPE_AGENT); }
__device__ __forceinline__ unsigned xb_xcc_id() { return (unsigned)__builtin_amdgcn_s_getreg((3 << 11) | 20) & 0xFu; }
#define XB_SPIN(cond, bar) do { unsigned _sp = 0; while (cond) { __builtin_amdgcn_s_sleep(1); \
    if ((++_sp & 255u) == 0u) { if (xb_ld(&(bar)[XB_TMO])) break; if (_sp > XB_SPIN_CAP) { atomicAdd(&(bar)[XB_TMO], 1u); break; } } } } while (0)
struct XcdBarrier { unsigned* bar; unsigned x; volatile LAS unsigned* st; };
__device__ __forceinline__ XcdBarrier xcd_barrier_post(unsigned* bar, volatile LAS unsigned* st) {
    XcdBarrier b; b.bar = bar; b.x = xb_xcc_id(); b.st = st;
    if (threadIdx.x == 0) (void)xb_add(&bar[XB_XCNT(b.x)], 1u);
    return b;
}
__device__ __forceinline__ void xcd_barrier_complete(unsigned* bar, unsigned x, unsigned& nloc, unsigned& nx) {
    const unsigned G = gridDim.x * gridDim.y * gridDim.z;
    unsigned sum, cnt, mine, sp = 0u;
    for (;;) {
        sum = 0u; cnt = 0u; mine = 0u;
#pragma unroll
        for (unsigned j = 0; j < 16; ++j) { const unsigned c = xb_ld(&bar[XB_XCNT(j)]); sum += c; cnt += (c > 0u) ? 1u : 0u; mine = (j == x) ? c : mine; }
        if (sum == G) break;
        __builtin_amdgcn_s_sleep(1);
        if ((++sp & 255u) == 0u) { if (xb_ld(&bar[XB_TMO])) break; if (sp > XB_SPIN_CAP) { atomicAdd(&bar[XB_TMO], 1u); break; } }
    }
    nloc = mine > 0u ? mine : 1u; nx = cnt > 0u ? cnt : 1u;
}
__device__ __forceinline__ void xcd_barrier(const XcdBarrier& b) {
    asm volatile("s_waitcnt vmcnt(0)" ::: "memory");
    __syncthreads();
    if (threadIdx.x == 0) {
        unsigned* bar = b.bar;
        __builtin_amdgcn_s_waitcnt(0);
        unsigned nloc = b.st[0], nx = b.st[1];
        if (nloc == 0u) { xcd_barrier_complete(bar, b.x, nloc, nx); b.st[0] = nloc; b.st[1] = nx; }
        const unsigned old = xb_add(&bar[XB_XSUB(b.x)], 1u);
        const unsigned gen = old / nloc;
        if (old + 1u == (gen + 1u) * nloc) {
            __builtin_amdgcn_fence(__ATOMIC_RELEASE, "agent");
            asm volatile("s_waitcnt vmcnt(0)" ::: "memory");
            const unsigned og = xb_add(&bar[XB_TOP], 1u);
            const unsigned tg = og / nx;
            if (og + 1u == (tg + 1u) * nx) xb_add(&bar[XB_TOPGEN], 1u);
            else XB_SPIN(xb_ld(&bar[XB_TOPGEN]) == tg, bar);
            __builtin_amdgcn_fence(__ATOMIC_ACQUIRE, "agent");
            xb_add(&bar[XB_XGEN(b.x)], 1u);
            asm volatile("s_waitcnt vmcnt(0)" ::: "memory");
        } else {
            XB_SPIN(xb_ld(&bar[XB_XGEN(b.x)]) == gen, bar);
            __builtin_amdgcn_fence(__ATOMIC_ACQUIRE, "agent");
            asm volatile("s_waitcnt vmcnt(0)" ::: "memory");
        }
    }
    __syncthreads();
}

constexpr int RING_BYTES = 131072;
constexpr int MISC_OFF = RING_BYTES + 320;
constexpr int LDS_BYTES = 147456;
constexpr int NWAVES = 8;
constexpr int CW_BAR = 4096;

constexpr size_t WB_WIN0 = WS_WB;
constexpr size_t WB_WGLU = WB_WIN0 + 4 * MiB;
constexpr size_t WB_WOUT0 = WB_WGLU + MiB / 2;
constexpr size_t WB_WIN1 = WB_WOUT0 + 2 * MiB;
constexpr size_t WB_WOUT1 = WB_WIN1 + 5 * MiB;
constexpr size_t WB_WAX = WB_WOUT1 + 5 * MiB / 2;
constexpr size_t WB_END = WB_WAX + MiB;
constexpr size_t MOE_WGU = 0, MOE_WD = 64 * MiB;

struct Frame {
    LAS unsigned char* lds;
    int tid, lane, wave, G, vcu;
};

__device__ __forceinline__ void transpose_item(const float* W, int N, int k0, int n0, bf16* WTrow0, int ldt, LAS float* scr, int lane) {
    f32x4 v[8];
#pragma unroll
    for (int i = 0; i < 8; ++i) v[i] = *(const f32x4*)(W + (size_t)(k0 + 4 * i + (lane >> 4)) * N + n0 + 4 * (lane & 15));
#pragma unroll
    for (int i = 0; i < 8; ++i) { LAS float* d = scr + (4 * i + (lane >> 4)) * 65 + 4 * (lane & 15); d[0] = v[i][0]; d[1] = v[i][1]; d[2] = v[i][2]; d[3] = v[i][3]; }
    LDS_WAIT(); asm volatile("" ::: "memory");
    const int c = lane & 3;
#pragma unroll
    for (int j = 0; j < 4; ++j) { const int n = (lane >> 2) + 16 * j; const LAS float* s = scr + (8 * c) * 65 + n;
        v4u o; o.x = pk2(s[0 * 65], s[1 * 65]); o.y = pk2(s[2 * 65], s[3 * 65]); o.z = pk2(s[4 * 65], s[5 * 65]); o.w = pk2(s[6 * 65], s[7 * 65]);
        *(GAS v4u*)(WTrow0 + (size_t)n * ldt + k0 + 8 * c) = o; }
    LDS_WAIT(); asm volatile("" ::: "memory");
}
constexpr int CI_WIN0 = 1024, CI_WGLU = 128, CI_WOUT0 = 512, CI_WIN1 = 1280, CI_WOUT1 = 640, CI_WAX = 160, CI_MOE = 24576;
constexpr int CI_SMALL = CI_WIN0 + CI_WGLU + CI_WOUT0 + CI_WIN1 + CI_WOUT1 + CI_WAX;
constexpr int CI_TOTAL = CI_SMALL + 2 * CI_MOE;
struct ArgsF { P p; int ph_lo, ph_hi, li, pad; };
typedef __attribute__((address_space(4))) const ArgsF CArgsF;
__device__ __forceinline__ void cvt_item(CArgsF* q, int it, LAS float* scr, int lane) {
    const float* W; int N, K, r = it; bf16* WT;
    if (r < CI_WIN0) { W = q->p.in[I_L0WIN]; K = D; N = NZ0; WT = (bf16*)(q->p.ws + WB_WIN0); }
    else if ((r -= CI_WIN0) < CI_WGLU) { W = q->p.in[I_WGLU]; K = 512; N = 512; WT = (bf16*)(q->p.ws + WB_WGLU); }
    else if ((r -= CI_WGLU) < CI_WOUT0) { W = q->p.in[I_L0WOUT]; K = D; N = D; WT = (bf16*)(q->p.ws + WB_WOUT0); }
    else if ((r -= CI_WOUT0) < CI_WIN1) { W = q->p.in[I_L1WIN]; K = D; N = NZ1; WT = (bf16*)(q->p.ws + WB_WIN1); }
    else if ((r -= CI_WIN1) < CI_WOUT1) { W = q->p.in[I_L1WOUT]; K = DRNN; N = D; WT = (bf16*)(q->p.ws + WB_WOUT1); }
    else if ((r -= CI_WOUT1) < CI_WAX) { const int blk = r >> 4, gsel = (r >> 3) & 1; r &= 7;
        W = (gsel ? q->p.in[I_WX] : q->p.in[I_WA]) + (size_t)blk * 128 * 128; K = 128; N = 128; WT = (bf16*)(q->p.ws + WB_WAX) + (size_t)(blk * 2 + gsel) * 128 * 128; }
    else { r -= CI_WAX; const int L = r >= CI_MOE; if (L) r -= CI_MOE; const int e = r / 768; r -= e * 768; const int which = r >> 8; r &= 255;
        unsigned char* mb = q->p.ws + (L ? WS_MOE1 : WS_MOE0);
        if (which < 2) {
            W = (L ? (which ? q->p.in[I_M1WU] : q->p.in[I_M1WG]) : (which ? q->p.in[I_M0WU] : q->p.in[I_M0WG])) + (size_t)e * D * 512; K = D; N = 512;
            const int kb = r / 8, nb = r % 8, n0 = nb * 64;
            bf16* dst = (bf16*)(mb + MOE_WGU) + ((size_t)e * 1024 + 256 * (n0 >> 7) + (n0 & 127) + 128 * which) * 1024;
            transpose_item(W, N, kb * 32, n0, dst, 1024, scr, lane); return; }
        W = (L ? q->p.in[I_M1WD] : q->p.in[I_M0WD]) + (size_t)e * 512 * D; K = 512; N = D; WT = (bf16*)(mb + MOE_WD) + (size_t)e * 1024 * 512; }
    const int nblk = N / 64, kb = r / nblk, nb = r % nblk;
    transpose_item(W, N, kb * 32, nb * 64, WT + (size_t)(nb * 64) * K, K, scr, lane);
}
template <class E>
__device__ __forceinline__ void meta_gemm(const Frame& F, const P& p, const bf16* A16, int lda, const bf16* Bt, int N, int K, const E& e) {
    const int lane = F.lane, r = lane & 15, q = lane >> 4, kc = K >> 3;
    LAS float* red = (LAS float*)F.lds;
    for (int tile = F.vcu; tile < N / 16; tile += F.G) {
        f32x4 acc = {0.f, 0.f, 0.f, 0.f};
        const bf16* ap = A16 + (size_t)r * lda + q * 8 + F.wave * kc; const bf16* bp = Bt + (size_t)(tile * 16 + r) * K + q * 8 + F.wave * kc;
#pragma unroll 5
        for (int k = 0; k < kc; k += 32) {
            const bf16x8 a = *(const bf16x8*)(ap + k); const bf16x8 b = *(const bf16x8*)(bp + k);
            acc = __builtin_amdgcn_mfma_f32_16x16x32_bf16(a, b, acc, 0, 0, 0);
        }
        *(LAS f32x4*)(red + (F.wave * 64 + lane) * 4) = acc;
        __syncthreads();
        if (F.wave == 0) {
#pragma unroll
            for (int w = 1; w < 8; ++w) acc += *(const LAS f32x4*)(red + (w * 64 + lane) * 4);
#pragma unroll
            for (int i = 0; i < 4; ++i) e.store(p, 0, MX + q * 4 + i, tile * 16 + r, acc[i], 0.f);
        }
        __syncthreads();
    }
}

struct FEpiZ0 {
    static constexpr bool PERM = true;
    bf16* Z;
    __device__ __forceinline__ void operator()(const pg8::f32x4 (&acc)[2][2][4][2], const pg8::Unit& u, int wr, int wc, int fr, int fq) const {
        const int row0 = u.pm * 256 + wr * 64 + fr, col0 = u.pn * 256 + wc * 32 + 8 * fq;
        const float sc = (u.pn == 2 || u.pn == 3) ? QSCALE : 1.f;
#pragma unroll
        for (int ai = 0; ai < 2; ++ai)
#pragma unroll
            for (int m = 0; m < 4; ++m) { bf16* rowp = Z + (size_t)(row0 + ai * 128 + m * 16) * NZ0 + col0;
#pragma unroll
                for (int bj = 0; bj < 2; ++bj) { const pg8::f32x4 v0 = acc[ai][bj][m][0] * sc, v1 = acc[ai][bj][m][1] * sc;
                    pg8::u32x4 w; w.x = pg8::cvt_pk_bf16(v0[0], v0[1]); w.y = pg8::cvt_pk_bf16(v0[2], v0[3]); w.z = pg8::cvt_pk_bf16(v1[0], v1[1]); w.w = pg8::cvt_pk_bf16(v1[2], v1[3]);
                    *(pg8::u32x4*)(rowp + bj * 128) = w; } }
    }
};


__device__ __forceinline__ float fast_sigmoid(float v) { return __builtin_amdgcn_rcpf(1.f + __builtin_amdgcn_exp2f(-1.4426950408889634f * v)); }
__device__ __forceinline__ float fast_gelu(float x) { const float u = x + 0.044715f * x * x * x; return x * __builtin_amdgcn_rcpf(1.f + __builtin_amdgcn_exp2f(-2.302208198f * u)); }
__device__ __forceinline__ pg8::u32x4 pack8(const pg8::f32x4& v0, const pg8::f32x4& v1) {
    pg8::u32x4 w; w.x = pg8::cvt_pk_bf16(v0[0], v0[1]); w.y = pg8::cvt_pk_bf16(v0[2], v0[3]); w.z = pg8::cvt_pk_bf16(v1[0], v1[1]); w.w = pg8::cvt_pk_bf16(v1[2], v1[3]); return w; }
__device__ __forceinline__ void unpack8(const pg8::u32x4& w, pg8::f32x4& v0, pg8::f32x4& v1) {
    v0[0] = __uint_as_float(w.x << 16); v0[1] = __uint_as_float(w.x & 0xffff0000u); v0[2] = __uint_as_float(w.y << 16); v0[3] = __uint_as_float(w.y & 0xffff0000u);
    v1[0] = __uint_as_float(w.z << 16); v1[1] = __uint_as_float(w.z & 0xffff0000u); v1[2] = __uint_as_float(w.w << 16); v1[3] = __uint_as_float(w.w & 0xffff0000u); }

struct FEpiGLU {
    static constexpr bool PERM = true;
    const bf16* YP; bf16* YM; const float* bias;
    __device__ __forceinline__ void operator()(const pg8::f32x4 (&acc)[2][2][4][2], const pg8::Unit& u, int wr, int wc, int fr, int fq) const {
        const int row0 = u.pm * 256 + wr * 64 + fr, col0 = u.pn * 256 + wc * 32 + 8 * fq;
#pragma unroll
        for (int bj = 0; bj < 2; ++bj) { const pg8::f32x4 b0 = *(const pg8::f32x4*)(bias + col0 + bj * 128), b1 = *(const pg8::f32x4*)(bias + col0 + bj * 128 + 4);
#pragma unroll
            for (int ai = 0; ai < 2; ++ai)
#pragma unroll
                for (int m = 0; m < 4; ++m) { const size_t row = (size_t)(row0 + ai * 128 + m * 16);
                    pg8::f32x4 y0, y1; unpack8(*(const pg8::u32x4*)(YP + row * 512 + col0 + bj * 128), y0, y1);
                    pg8::f32x4 v0 = acc[ai][bj][m][0] + b0, v1 = acc[ai][bj][m][1] + b1;
#pragma unroll
                    for (int j = 0; j < 4; ++j) { v0[j] = y0[j] * fast_sigmoid(v0[j]); v1[j] = y1[j] * fast_sigmoid(v1[j]); }
                    *(pg8::u32x4*)(YM + row * D + col0 + bj * 128) = pack8(v0, v1); asm volatile("" ::: "memory"); } }
    }
};
struct FEpiOut0 {
    static constexpr bool PERM = true;
    const float* X; bf16* R1;
    __device__ __forceinline__ void operator()(const pg8::f32x4 (&acc)[2][2][4][2], const pg8::Unit& u, int wr, int wc, int fr, int fq) const {
        const int row0 = u.pm * 256 + wr * 64 + fr, col0 = u.pn * 256 + wc * 32 + 8 * fq;
#pragma unroll
        for (int ai = 0; ai < 2; ++ai)
#pragma unroll
            for (int m = 0; m < 4; ++m) { const size_t off = (size_t)(row0 + ai * 128 + m * 16) * D + col0;
#pragma unroll
                for (int bj = 0; bj < 2; ++bj) { const pg8::f32x4 x0 = *(const pg8::f32x4*)(X + off + bj * 128), x1 = *(const pg8::f32x4*)(X + off + bj * 128 + 4);
                    *(pg8::u32x4*)(R1 + off + bj * 128) = pack8(x0 * ALPHA + acc[ai][bj][m][0], x1 * ALPHA + acc[ai][bj][m][1]); }
                asm volatile("" ::: "memory"); }
    }
};
struct FEpiZ1 {
    static constexpr bool PERM = true;
    bf16* Z;
    __device__ __forceinline__ void operator()(const pg8::f32x4 (&acc)[2][2][4][2], const pg8::Unit& u, int wr, int wc, int fr, int fq) const {
        const int row0 = u.pm * 256 + wr * 64 + fr, col0 = u.pn * 256 + wc * 32 + 8 * fq; const bool g = u.pn < 5;
#pragma unroll
        for (int ai = 0; ai < 2; ++ai)
#pragma unroll
            for (int m = 0; m < 4; ++m) { bf16* rowp = Z + (size_t)(row0 + ai * 128 + m * 16) * NZ1 + col0;
#pragma unroll
                for (int bj = 0; bj < 2; ++bj) { pg8::f32x4 v0 = acc[ai][bj][m][0], v1 = acc[ai][bj][m][1];
                    if (g) {
#pragma unroll
                        for (int j = 0; j < 4; ++j) { v0[j] = fast_gelu(v0[j]); v1[j] = fast_gelu(v1[j]); } }
                    *(pg8::u32x4*)(rowp + bj * 128) = pack8(v0, v1); }
                asm volatile("" ::: "memory"); }
    }
};
struct FEpiOut1 {
    static constexpr bool PERM = true;
    const bf16* Hb; bf16* R1;
    __device__ __forceinline__ void operator()(const pg8::f32x4 (&acc)[2][2][4][2], const pg8::Unit& u, int wr, int wc, int fr, int fq) const {
        const int row0 = u.pm * 256 + wr * 64 + fr, col0 = u.pn * 256 + wc * 32 + 8 * fq;
#pragma unroll
        for (int ai = 0; ai < 2; ++ai)
#pragma unroll
            for (int m = 0; m < 4; ++m) { const size_t off = (size_t)(row0 + ai * 128 + m * 16) * D + col0;
#pragma unroll
                for (int bj = 0; bj < 2; ++bj) { pg8::f32x4 h0, h1; unpack8(*(const pg8::u32x4*)(Hb + off + bj * 128), h0, h1);
                    *(pg8::u32x4*)(R1 + off + bj * 128) = pack8(h0 * ALPHA + acc[ai][bj][m][0], h1 * ALPHA + acc[ai][bj][m][1]); }
                asm volatile("" ::: "memory"); }
    }
};

template <bool GATHER_, int NTN, int KK, int BROWS>
struct MoeOrder {
    static constexpr bool GATHER = GATHER_;
    const char* A; const char* Bt; const int* list; const int* cnt; const volatile LAS int* tp; int G, c, total;
    __device__ bool next(int i, pg8::Unit& u) const {
        const long L = (long)i * G + c; if (L >= total) return false;
        const int gt = (int)(L / NTN), pn = (int)(L % NTN);
        int e = 0;
#pragma unroll 1
        for (int k = 16; k >= 1; k >>= 1) if (__builtin_amdgcn_readfirstlane(tp[e + k]) <= gt) e += k;
        const int mt = gt - __builtin_amdgcn_readfirstlane(tp[e]);
        u.pm = gt; u.pn = pn; u.ex = e | (mt << 8); { const int left = cnt[CNT_IDX(e)] - mt * 256; u.nrow = left < 256 ? left : 256; }
        u.a = GATHER ? A : A + (size_t)gt * 256 * KK * 2; u.b = Bt + ((size_t)e * BROWS + (size_t)pn * 256) * KK * 2; return true;
    }
    __device__ __forceinline__ void voffs(const pg8::Unit& u, int tid, unsigned (&v0)[2], unsigned (&v1)[2]) const {
        const int e = u.ex & 255, mt = u.ex >> 8; const int* lp = list + (size_t)e * LIST_CAP + mt * 256;
#pragma unroll
        for (int i = 0; i < 2; ++i) { int R, C; pg8::stage_rc(tid * 16 + i * 8192, R, C);
            const int t0 = R < u.nrow ? (lp[R] >> 1) : 0, t1 = (R + 128) < u.nrow ? (lp[R + 128] >> 1) : 0;
            v0[i] = (unsigned)(t0 * KK + C) * 2u; v1[i] = (unsigned)(t1 * KK + C) * 2u; }
    }
};
struct FEpiMoe1 {
    static constexpr bool PERM = true;
    bf16* HID;
    __device__ __forceinline__ void operator()(const pg8::f32x4 (&acc)[2][2][4][2], const pg8::Unit& u, int wr, int wc, int fr, int fq) const {
        const int row0 = u.pm * 256 + wr * 64 + fr, col0 = u.pn * 128 + wc * 32 + 8 * fq;
#pragma unroll
        for (int ai = 0; ai < 2; ++ai)
#pragma unroll
            for (int m = 0; m < 4; ++m) { pg8::f32x4 v0, v1;
#pragma unroll
                for (int j = 0; j < 4; ++j) { const float g0 = acc[ai][0][m][0][j], g1 = acc[ai][0][m][1][j];
                    v0[j] = g0 * fast_sigmoid(g0) * acc[ai][1][m][0][j]; v1[j] = g1 * fast_sigmoid(g1) * acc[ai][1][m][1][j]; }
                *(pg8::u32x4*)(HID + (size_t)(row0 + ai * 128 + m * 16) * 512 + col0) = pack8(v0, v1); }
    }
};
struct FEpiMoe2 {
    static constexpr bool PERM = true;
    bf16* Y2; const int* list; const float* gate;
    __device__ __forceinline__ void operator()(const pg8::f32x4 (&acc)[2][2][4][2], const pg8::Unit& u, int wr, int wc, int fr, int fq) const {
        const int e = u.ex & 255, mt = u.ex >> 8; const int* lp = list + (size_t)e * LIST_CAP + mt * 256;
        const int col0 = u.pn * 256 + wc * 32 + 8 * fq;
#pragma unroll
        for (int ai = 0; ai < 2; ++ai)
#pragma unroll
            for (int m = 0; m < 4; ++m) { const int r = ai * 128 + wr * 64 + m * 16 + fr;
                if (r < u.nrow) { const int asg = lp[r]; const float gt = gate[asg]; bf16* rowp = Y2 + (size_t)asg * D + col0;
#pragma unroll
                    for (int bj = 0; bj < 2; ++bj) *(pg8::u32x4*)(rowp + bj * 128) = pack8(acc[ai][bj][m][0] * gt, acc[ai][bj][m][1] * gt); } }
    }
};
__device__ __forceinline__ int moe_prefix(const int* cnt, volatile LAS int* tp, int tid) {
    if (tid == 0) { int acc = 0; for (int e = 0; e < NE; ++e) { tp[e] = acc; acc += (cnt[CNT_IDX(e)] + 255) >> 8; } tp[NE] = acc; }
    __syncthreads();
    return __builtin_amdgcn_readfirstlane(tp[NE]);
}


__device__ __forceinline__ void load16bf(const bf16* ptr, float (&v)[16]) {
    const pg8::u32x4 a = *(const pg8::u32x4*)ptr, b = *(const pg8::u32x4*)(ptr + 8);
    pg8::f32x4 x0, x1, x2, x3; unpack8(a, x0, x1); unpack8(b, x2, x3);
#pragma unroll
    for (int j = 0; j < 4; ++j) { v[j] = x0[j]; v[4 + j] = x1[j]; v[8 + j] = x2[j]; v[12 + j] = x3[j]; }
}
__device__ __forceinline__ void store16bf(bf16* ptr, const float (&v)[16]) {
    pg8::u32x4 a, b;
    a.x = pk2(v[0], v[1]); a.y = pk2(v[2], v[3]); a.z = pk2(v[4], v[5]); a.w = pk2(v[6], v[7]);
    b.x = pk2(v[8], v[9]); b.y = pk2(v[10], v[11]); b.z = pk2(v[12], v[13]); b.w = pk2(v[14], v[15]);
    *(pg8::u32x4*)ptr = a; *(pg8::u32x4*)(ptr + 8) = b;
}
__device__ __forceinline__ void ln16(float (&v)[16], const float* g, const float* b, int c0) {
    float s = 0.f;
#pragma unroll
    for (int j = 0; j < 16; ++j) s += v[j];
    const float mean = wave_sum(s) * (1.f / D); float q = 0.f;
#pragma unroll
    for (int j = 0; j < 16; ++j) { v[j] -= mean; q += v[j] * v[j]; }
    const float rstd = 1.f / sqrtf(wave_sum(q) * (1.f / D) + LN_EPS);
#pragma unroll
    for (int j4 = 0; j4 < 4; ++j4) { const pg8::f32x4 gg = *(const pg8::f32x4*)(g + c0 + 4 * j4), bb = *(const pg8::f32x4*)(b + c0 + 4 * j4);
#pragma unroll
        for (int j = 0; j < 4; ++j) v[4 * j4 + j] = v[4 * j4 + j] * rstd * gg[j] + bb[j]; }
}
constexpr size_t WB_WR = 19 * MiB + 576 * 1024;
__device__ __forceinline__ void router_table(const P& p, int gt, int NGT) {
    for (int it = gt; it < 2 * 48 * 1024; it += NGT) {
        const int L = it / (48 * 1024), r = it % (48 * 1024), c = r >> 10, k = r & 1023;
        float w = 0.f;
        if (c < 4) w = (L ? p.in[I_M1WC] : p.in[I_M0WC])[(size_t)k * 4 + c];
        else if (c < 36) w = (L ? p.in[I_M1WF] : p.in[I_M0WF])[((size_t)((c - 4) >> 3) * D + k) * 8 + ((c - 4) & 7)];
        const bf16 hi = f2bf(w); const bf16 lo = f2bf(w - bf2f(hi));
        bf16* T = (bf16*)(p.ws + WB_WR) + (size_t)L * 96 * 1024;
        T[(size_t)c * 1024 + k] = hi; T[(size_t)(48 + c) * 1024 + k] = lo;
    }
}
template <int L> __device__ __forceinline__ void router_phase(const Frame& F, const P& p, int gw, int NGW, LAS unsigned char* lds) {
    const bf16* R1 = (const bf16*)(p.ws + WS_R1); bf16* Hb = (bf16*)(p.ws + WS_HB);
    const float* g = p.in[L ? I_L1LN1G : I_L0LN1G]; const float* bb = p.in[L ? I_L1LN1B : I_L0LN1B];
    const float* bc = p.in[L ? I_M1BC : I_M0BC]; const float* bfi = p.in[L ? I_M1BF : I_M0BF];
    const bf16* WR = (const bf16*)(p.ws + WB_WR) + (size_t)L * 96 * 1024;
    int* cnt = (int*)(p.ws + WS_CTL) + (L ? CW_CNT1 : CW_CNT0);
    int* list = (int*)(p.ws + WS_ROUTE); float* gate = (float*)(p.ws + WS_GATE);
    LAS int* lcnt = (LAS int*)lds; LAS int* lbase = lcnt + 32; LAS int* ent = lcnt + 64;
    LAS float* lg = (LAS float*)(lds + 4096) + F.wave * (16 * 48);
    const int lane = F.lane, row = lane & 15, kq = lane >> 4;
    if (F.tid < 32) lcnt[F.tid] = 0;
    __syncthreads();
    const int tile = F.wave * F.G + F.vcu;
    const bool active = tile < MR / 16;
    if (active) {
        const size_t r = (size_t)tile * 16 + row;
        float s = 0.f, q = 0.f;
#pragma unroll 16
        for (int ks = 0; ks < 32; ++ks) { pg8::f32x4 a, b2; unpack8(*(const pg8::u32x4*)(R1 + r * D + 32 * ks + 8 * kq), a, b2);
#pragma unroll
            for (int e = 0; e < 4; ++e) { s += a[e] + b2[e]; q += a[e] * a[e] + b2[e] * b2[e]; } }
        s += __shfl_xor(s, 16); s += __shfl_xor(s, 32); q += __shfl_xor(q, 16); q += __shfl_xor(q, 32);
        const float mean = s * (1.f / D);
        const float rstd = 1.f / sqrtf(fmaxf(q * (1.f / D) - mean * mean, 0.f) + LN_EPS);
        f32x4 acc[6];
#pragma unroll
        for (int nt = 0; nt < 6; ++nt) acc[nt] = (f32x4){0.f, 0.f, 0.f, 0.f};
#pragma unroll 8
        for (int ks = 0; ks < 32; ++ks) {
            const int c0 = 32 * ks + 8 * kq;
            pg8::f32x4 a, b2; unpack8(*(const pg8::u32x4*)(R1 + r * D + c0), a, b2);
            const pg8::f32x4 g0 = *(const pg8::f32x4*)(g + c0), g1 = *(const pg8::f32x4*)(g + c0 + 4), o0 = *(const pg8::f32x4*)(bb + c0), o1 = *(const pg8::f32x4*)(bb + c0 + 4);
            a = (a - mean) * rstd * g0 + o0; b2 = (b2 - mean) * rstd * g1 + o1;
            const pg8::u32x4 hw = pack8(a, b2);
            *(pg8::u32x4*)(Hb + r * D + c0) = hw;
            const bf16x8 af = __builtin_bit_cast(bf16x8, hw);
#pragma unroll
            for (int nt = 0; nt < 6; ++nt) { const bf16x8 bq = *(const bf16x8*)(WR + (size_t)(16 * nt + row) * 1024 + c0);
                acc[nt] = __builtin_amdgcn_mfma_f32_16x16x32_bf16(af, bq, acc[nt], 0, 0, 0); }
        }
#pragma unroll
        for (int nt = 0; nt < 3; ++nt)
#pragma unroll
            for (int e = 0; e < 4; ++e) lg[(4 * kq + e) * 48 + 16 * nt + row] = acc[nt][e] + acc[nt + 3][e];
        LDS_WAIT(); asm volatile("" ::: "memory");
        if (lane < 16) {
            const LAS float* lr = lg + lane * 48; const int rr = tile * 16 + lane;
            float lc[4];
#pragma unroll
            for (int c4 = 0; c4 < 4; ++c4) lc[c4] = lr[c4] + bc[c4];
            int grp = 0; float mxc = lc[0];
#pragma unroll
            for (int c4 = 1; c4 < 4; ++c4) if (lc[c4] > mxc) { mxc = lc[c4]; grp = c4; }
            float se = 0.f;
#pragma unroll
            for (int c4 = 0; c4 < 4; ++c4) se += expf(lc[c4] - mxc);
            const float pgrp = 1.f / se;
            float lf[8];
#pragma unroll
            for (int e8 = 0; e8 < 8; ++e8) lf[e8] = lr[4 + grp * 8 + e8] + bfi[grp * 8 + e8];
            int i0 = 0; float v0 = lf[0];
#pragma unroll
            for (int e8 = 1; e8 < 8; ++e8) if (lf[e8] > v0) { v0 = lf[e8]; i0 = e8; }
            int i1 = 0; float v1 = -1e30f;
#pragma unroll
            for (int e8 = 0; e8 < 8; ++e8) if (e8 != i0 && lf[e8] > v1) { v1 = lf[e8]; i1 = e8; }
            const float e1 = expf(v1 - v0); const float g0 = pgrp / (1.f + e1), g1 = pgrp * e1 / (1.f + e1);
            const int ea = grp * 8 + i0, eb = grp * 8 + i1;
            const int pa = __hip_atomic_fetch_add(lcnt + ea, 1, __ATOMIC_RELAXED, __HIP_MEMORY_SCOPE_WORKGROUP);
            const int pb = __hip_atomic_fetch_add(lcnt + eb, 1, __ATOMIC_RELAXED, __HIP_MEMORY_SCOPE_WORKGROUP);
            LAS int* en = ent + (F.wave * 16 + lane) * 4; en[0] = ea; en[1] = pa; en[2] = eb; en[3] = pb;
            gate[rr * 2] = g0; gate[rr * 2 + 1] = g1;
        }
    }
    __syncthreads();
    if (F.tid < 32) { const int c = lcnt[F.tid]; lbase[F.tid] = c ? atomicAdd(&cnt[CNT_IDX(F.tid)], c) : 0; }
    __syncthreads();
    if (active && lane < 16) { const LAS int* en = ent + (F.wave * 16 + lane) * 4; const int rr = tile * 16 + lane;
        list[(size_t)en[0] * LIST_CAP + lbase[en[0]] + en[1]] = rr * 2; list[(size_t)en[2] * LIST_CAP + lbase[en[2]] + en[3]] = rr * 2 + 1; }
    __syncthreads();
}
template <int L> __device__ __forceinline__ void combine_phase(const Frame& F, const P& p, int gw, int NGW) {
    bf16* Hb = (bf16*)(p.ws + WS_HB); const bf16* Y2 = (const bf16*)(p.ws + WS_Z);
    const float* g = p.in[L ? I_L1LN2G : I_L0LN2G]; const float* bb = p.in[L ? I_L1LN2B : I_L0LN2B];
    const int lane = F.lane, c0 = lane * 16;
    for (int r = gw; r < (L ? MX : MR); r += NGW) {
        float v[16], a[16], b[16]; load16bf(Hb + (size_t)r * D + c0, v); load16bf(Y2 + (size_t)(2 * r) * D + c0, a); load16bf(Y2 + (size_t)(2 * r + 1) * D + c0, b);
#pragma unroll
        for (int j = 0; j < 16; ++j) v[j] = ALPHA * v[j] + a[j] + b[j];
        ln16(v, g, bb, c0);
        if (L == 0) store16bf(Hb + (size_t)r * D + c0, v);
        else {
#pragma unroll
            for (int j4 = 0; j4 < 4; ++j4) *(pg8::f32x4*)(p.out + (size_t)r * D + c0 + 4 * j4) = (pg8::f32x4){v[4 * j4], v[4 * j4 + 1], v[4 * j4 + 2], v[4 * j4 + 3]};
        }
    }
}

namespace att {
typedef float f32x16 __attribute__((ext_vector_type(16)));
typedef short s16x4 __attribute__((ext_vector_type(4)));
typedef short v4i16_t __attribute__((ext_vector_type(4)));
constexpr int KS = 144, KBYTES = 64 * KS;
constexpr int VS = 320, VBYTES = 64 * VS;
constexpr int STG = 2 * KBYTES + VBYTES;
constexpr float THR = 6.0f;
__device__ __forceinline__ int crow(int r, int hi) { return (r & 3) + 8 * (r >> 2) + 4 * hi; }
__device__ __forceinline__ s16x4 vtr(const LAS unsigned char* p) { return __builtin_bit_cast(s16x4, __builtin_amdgcn_ds_read_tr16_b64_v4i16((LAS v4i16_t*)p)); }

__device__ __forceinline__ void attn_unit(const Frame& F, const P& p, LAS unsigned char* lds, int b, int h, int qb, bool is_meta, float lam) {
    const bf16* Z = (const bf16*)(p.ws + WS_Z); bf16* YM = (bf16*)(p.ws + WS_YM);
    const int tid = F.tid, lane = F.lane, wid = F.wave, qsub = wid & 3, c = wid >> 2, r32 = lane & 31, hi = lane >> 5;
    const bool wave_active = is_meta ? (qsub == 0) : true;
    const int ntiles = is_meta ? 1 : 2 * qb + 3;
    const int my_ntiles = is_meta ? 1 : 2 * qb + 2 + (qsub >= 2 ? 1 : 0);
    const size_t qrow = is_meta ? (size_t)(MX + (r32 < 16 ? r32 : 15)) : (size_t)b * SEQ + qb * 128 + qsub * 32 + r32;
    bf16x8 qf[4];
#pragma unroll
    for (int d = 0; d < 4; ++d) qf[d] = *(const bf16x8*)(Z + qrow * NZ0 + 512 + h * 128 + c * 64 + d * 16 + hi * 8);
    v4u kregA[2], vregA[2], kregB[2], vregB[2];
    auto gload = [&](int t, v4u (&kreg)[2], v4u (&vreg)[2]) {
#pragma unroll
        for (int i = 0; i < 2; ++i) { const int id = tid + 512 * i, row = id >> 4, ch = id & 15;
            long grow = t == 0 ? (row < 16 ? (long)(MX + row) : -1L) : (long)b * SEQ + 64 * (t - 1) + row;
            if (grow >= 0) { kreg[i] = *(const v4u*)(Z + (size_t)grow * NZ0 + 1024 + h * 128 + ch * 8); vreg[i] = *(const v4u*)(Z + (size_t)grow * NZ0 + 1536 + h * 128 + ch * 8); }
            else { kreg[i] = (v4u){0u, 0u, 0u, 0u}; vreg[i] = (v4u){0u, 0u, 0u, 0u}; } }
    };
    auto sstore = [&](int buf, const v4u (&kreg)[2], const v4u (&vreg)[2]) {
#pragma unroll
        for (int i = 0; i < 2; ++i) { const int id = tid + 512 * i, row = id >> 4, ch = id & 15;
            *(LAS v4u*)(lds + buf * STG + (ch >> 3) * KBYTES + row * KS + (ch & 7) * 16) = kreg[i];
            *(LAS v4u*)(lds + buf * STG + 2 * KBYTES + row * VS + ch * 16) = vreg[i]; }
    };
    f32x16 o[4];
#pragma unroll
    for (int d = 0; d < 4; ++d) o[d] = f32x16{};
    float m = -1e30f, l = 0.f;
    gload(0, kregA, vregA); sstore(0, kregA, vregA);
    if (ntiles > 1) gload(1, kregA, vregA);
    __syncthreads();
    auto compute = [&](int t, int buf) {
        if (wave_active && t < my_ntiles) {
            const LAS unsigned char* Kc = lds + buf * STG + c * KBYTES + r32 * KS + hi * 16;
            f32x16 p0 = f32x16{}, p1 = f32x16{};
#pragma unroll
            for (int d = 0; d < 4; ++d) {
                const bf16x8 k0 = *(const LAS bf16x8*)(Kc + d * 32), k1 = *(const LAS bf16x8*)(Kc + 32 * KS + d * 32);
                p0 = __builtin_amdgcn_mfma_f32_32x32x16_bf16(k0, qf[d], p0, 0, 0, 0);
                p1 = __builtin_amdgcn_mfma_f32_32x32x16_bf16(k1, qf[d], p1, 0, 0, 0);
            }
            __builtin_amdgcn_sched_barrier(0);
            if (t == 0) {
#pragma unroll
                for (int r = 0; r < 16; ++r) { if (r >= 8) p0[r] = -1e30f; p1[r] = -1e30f; }
            }
            float rm = fmaxf(p0[0], p1[0]);
#pragma unroll
            for (int r = 1; r < 16; ++r) rm = fmaxf(rm, fmaxf(p0[r], p1[r]));
            rm = fmaxf(rm, __shfl_xor(rm, 32));
            if (__any(rm > m + THR)) {
                const float mn = fmaxf(m, rm), alpha = __builtin_amdgcn_exp2f(m - mn);
                m = mn; l *= alpha;
#pragma unroll
                for (int r = 0; r < 16; ++r) { const float ar = __shfl(alpha, crow(r, hi));
#pragma unroll
                    for (int d = 0; d < 4; ++d) o[d][r] *= ar; }
            }
            float ls = 0.f;
#pragma unroll
            for (int r = 0; r < 16; ++r) { p0[r] = __builtin_amdgcn_exp2f(p0[r] - m); p1[r] = __builtin_amdgcn_exp2f(p1[r] - m); ls += p0[r] + p1[r]; }
            l += ls;
            bf16x8 pa[4];
            { v4u w;
              w.x = pg8::cvt_pk_bf16(p0[0], p0[1]); w.y = pg8::cvt_pk_bf16(p0[2], p0[3]); w.z = pg8::cvt_pk_bf16(p0[4], p0[5]); w.w = pg8::cvt_pk_bf16(p0[6], p0[7]); pa[0] = __builtin_bit_cast(bf16x8, w);
              w.x = pg8::cvt_pk_bf16(p0[8], p0[9]); w.y = pg8::cvt_pk_bf16(p0[10], p0[11]); w.z = pg8::cvt_pk_bf16(p0[12], p0[13]); w.w = pg8::cvt_pk_bf16(p0[14], p0[15]); pa[1] = __builtin_bit_cast(bf16x8, w);
              w.x = pg8::cvt_pk_bf16(p1[0], p1[1]); w.y = pg8::cvt_pk_bf16(p1[2], p1[3]); w.z = pg8::cvt_pk_bf16(p1[4], p1[5]); w.w = pg8::cvt_pk_bf16(p1[6], p1[7]); pa[2] = __builtin_bit_cast(bf16x8, w);
              w.x = pg8::cvt_pk_bf16(p1[8], p1[9]); w.y = pg8::cvt_pk_bf16(p1[10], p1[11]); w.z = pg8::cvt_pk_bf16(p1[12], p1[13]); w.w = pg8::cvt_pk_bf16(p1[14], p1[15]); pa[3] = __builtin_bit_cast(bf16x8, w); }
            __builtin_amdgcn_sched_barrier(0);
            const LAS unsigned char* Vb = lds + buf * STG + 2 * KBYTES + (4 * hi + ((lane & 15) >> 2)) * VS + (16 * ((lane >> 4) & 1) + 4 * (lane & 3)) * 2;
#pragma unroll
            for (int d = 0; d < 4; ++d)
#pragma unroll
                for (int s = 0; s < 4; ++s) {
                    const s16x4 lo = vtr(Vb + (16 * s) * VS + d * 64), hh = vtr(Vb + (16 * s + 8) * VS + d * 64);
                    const bf16x8 vf = (bf16x8){lo[0], lo[1], lo[2], lo[3], hh[0], hh[1], hh[2], hh[3]};
                    o[d] = __builtin_amdgcn_mfma_f32_32x32x16_bf16(pa[s], vf, o[d], 0, 0, 0);
                    if (s == 3) __builtin_amdgcn_sched_barrier(0);
                }
        }
    };
#pragma unroll 1
    for (int t = 0; t < ntiles; t += 2) {
        if (t + 2 < ntiles) gload(t + 2, kregB, vregB);
        compute(t, 0);
        if (t + 1 < ntiles) sstore(1, kregA, vregA);
        __syncthreads();
        if (t + 1 >= ntiles) break;
        if (t + 3 < ntiles) gload(t + 3, kregA, vregA);
        compute(t + 1, 1);
        if (t + 2 < ntiles) sstore(0, kregB, vregB);
        __syncthreads();
    }
    const float lt = l + __shfl_xor(l, 32);
    const float inv = (c == 1 ? lam : 1.f) / lt;
#pragma unroll
    for (int r = 0; r < 16; ++r) { const float ir = __shfl(inv, crow(r, hi));
#pragma unroll
        for (int d = 0; d < 4; ++d) o[d][r] *= ir; }
    LAS float* ex = (LAS float*)(lds) + qsub * 4224;
    if (c == 1 && wave_active) {
#pragma unroll
        for (int d = 0; d < 4; ++d)
#pragma unroll
            for (int r = 0; r < 16; ++r) ex[(d * 16 + r) * 64 + lane] = o[d][r];
    }
    __syncthreads();
    if (c == 0 && wave_active) {
#pragma unroll
        for (int d = 0; d < 4; ++d)
#pragma unroll
            for (int r = 0; r < 16; ++r) o[d][r] -= ex[(d * 16 + r) * 64 + lane];
        LDS_WAIT(); asm volatile("" ::: "memory");
#pragma unroll
        for (int d = 0; d < 4; ++d)
#pragma unroll
            for (int r = 0; r < 16; ++r) ex[(4 * hi) * 132 + r32 + ((r & 3) + 8 * (r >> 2)) * 132 + 32 * d] = o[d][r];
        LDS_WAIT(); asm volatile("" ::: "memory");
        const int q = r32, half = hi;
        float ss = 0.f;
#pragma unroll
        for (int k = 0; k < 16; ++k) { const pg8::f32x4 x = *(const LAS pg8::f32x4*)(ex + q * 132 + 64 * half + 4 * k);
            ss += (x[0] * x[0] + x[1] * x[1]) + (x[2] * x[2] + x[3] * x[3]); }
        ss += __shfl_xor(ss, 32);
        const float rs = (1.f - LAM_INIT) / sqrtf(ss * (1.f / 128.f) + LN_EPS);
        const float* sg = p.in[I_SUBLN] + 64 * half;
        const size_t orow = is_meta ? (size_t)(MX + q) : (size_t)b * SEQ + qb * 128 + qsub * 32 + q;
        if (!is_meta || q < 16) {
            bf16* op = YM + orow * D + 512 + h * 128 + 64 * half;
#pragma unroll
            for (int k = 0; k < 8; ++k) { const pg8::f32x4 g0 = *(const pg8::f32x4*)(sg + 8 * k), g1 = *(const pg8::f32x4*)(sg + 8 * k + 4);
                const pg8::f32x4 x0 = *(const LAS pg8::f32x4*)(ex + q * 132 + 64 * half + 8 * k);
                const pg8::f32x4 x1 = *(const LAS pg8::f32x4*)(ex + q * 132 + 64 * half + 8 * k + 4);
                *(pg8::u32x4*)(op + 8 * k) = pack8(x0 * g0 * rs, x1 * g1 * rs);
                asm volatile("" ::: "memory"); }
        }
    }
    __syncthreads();
}

__device__ __forceinline__ void attn_phase(const Frame& F, const P& p, LAS unsigned char* lds) {
    const float l1 = wave_sum(p.in[I_LQ1][F.lane] * p.in[I_LK1][F.lane]);
    const float l2 = wave_sum(p.in[I_LQ2][F.lane] * p.in[I_LK2][F.lane]);
    const float lam = expf(l1) - expf(l2) + LAM_INIT;
    const int npair = (F.vcu < 256) ? 1 : 0;
    const int nun = 2 * npair + (F.vcu < 4 ? 1 : 0);
#pragma unroll 1
    for (int u = 0; u < nun; ++u) {
        const int pr = F.vcu, bh = pr >> 3, s = pr & 7;
        const bool is_meta = (u == 2 * npair);
        const int b = is_meta ? 0 : (bh >> 2), h = is_meta ? F.vcu : (bh & 3), qb = is_meta ? 0 : (u == 0 ? 15 - s : s);
        attn_unit(F, p, lds, b, h, qb, is_meta, lam);
    }
}
}
namespace lru {
constexpr size_t WS_XC = WS_MOE0;
__device__ __forceinline__ size_t seq_row(int b, int s) { return s < NMETA ? (size_t)(MX + s) : (size_t)b * SEQ + (s - NMETA); }

__device__ __forceinline__ void conv_phase(const Frame& F, const P& p) {
    const bf16* Z = (const bf16*)(p.ws + WS_Z); bf16* XC = (bf16*)(p.ws + WS_XC);
    const float* cw = p.in[I_CONVW]; const float* cb = p.in[I_CONVB];
    const int gt = (F.vcu * NWAVES + F.wave) * 64 + F.lane, NGT = F.G * NWAVES * 64;
    for (int it = gt; it < 513 * 160; it += NGT) {
        const int seg = it / 160, c8 = (it % 160) * 8;
        const int b = seg < 512 ? seg >> 6 : 0, s0 = seg < 512 ? NMETA + 32 * (seg & 63) : 0, len = seg < 512 ? 32 : NMETA;
        float w[4][8], bias[8];
#pragma unroll
        for (int j = 0; j < 4; ++j) { const pg8::f32x4 w0 = *(const pg8::f32x4*)(cw + j * DRNN + c8), w1 = *(const pg8::f32x4*)(cw + j * DRNN + c8 + 4);
#pragma unroll
            for (int e2 = 0; e2 < 4; ++e2) { w[j][e2] = w0[e2]; w[j][4 + e2] = w1[e2]; } }
        { const pg8::f32x4 b0 = *(const pg8::f32x4*)(cb + c8), b1 = *(const pg8::f32x4*)(cb + c8 + 4);
#pragma unroll
          for (int e2 = 0; e2 < 4; ++e2) { bias[e2] = b0[e2]; bias[4 + e2] = b1[e2]; } }
        pg8::f32x4 h0[3], h1[3];
#pragma unroll
        for (int j = 0; j < 3; ++j) { const int sj = s0 - 3 + j;
            if (sj >= 0) unpack8(*(const pg8::u32x4*)(Z + seq_row(b, sj) * NZ1 + DRNN + c8), h0[j], h1[j]);
            else { h0[j] = (pg8::f32x4){0.f, 0.f, 0.f, 0.f}; h1[j] = (pg8::f32x4){0.f, 0.f, 0.f, 0.f}; } }
#pragma unroll 4
        for (int i = 0; i < len; ++i) {
            const size_t row = seq_row(b, s0 + i);
            pg8::f32x4 x0, x1; unpack8(*(const pg8::u32x4*)(Z + row * NZ1 + DRNN + c8), x0, x1);
            pg8::f32x4 o0, o1;
#pragma unroll
            for (int e2 = 0; e2 < 4; ++e2) {
                o0[e2] = bias[e2] + h0[0][e2] * w[0][e2] + h0[1][e2] * w[1][e2] + h0[2][e2] * w[2][e2] + x0[e2] * w[3][e2];
                o1[e2] = bias[4 + e2] + h1[0][e2] * w[0][4 + e2] + h1[1][e2] * w[1][4 + e2] + h1[2][e2] * w[2][4 + e2] + x1[e2] * w[3][4 + e2]; }
            *(pg8::u32x4*)(XC + row * DRNN + c8) = pack8(o0, o1);
            h0[0] = h0[1]; h0[1] = h0[2]; h0[2] = x0; h1[0] = h1[1]; h1[1] = h1[2]; h1[2] = x1;
        }
    }
}

__device__ __forceinline__ void scan_unit(const Frame& F, const P& p, int b, int n, int j) {
    const bf16* Z = (const bf16*)(p.ws + WS_Z); const bf16* XC = (const bf16*)(p.ws + WS_XC); bf16* Y1 = (bf16*)(p.ws + WS_YM);
    const bf16* WAX = (const bf16*)(p.ws + WB_WAX);
    const int lane = F.lane, col = lane & 15, grp = lane >> 4, ch = n * 128 + 16 * j + col;
    bf16x8 bw[2][4];
#pragma unroll
    for (int g = 0; g < 2; ++g)
#pragma unroll
        for (int ks = 0; ks < 4; ++ks) bw[g][ks] = *(const bf16x8*)(WAX + ((size_t)(n * 2 + g) * 128 + 16 * j + col) * 128 + 32 * ks + 8 * grp);
    bf16x8 ident;
    { const int kl = 16 * (j & 1) + col;
#pragma unroll
      for (int e = 0; e < 8; ++e) ident[e] = (grp == (kl >> 3) && e == (kl & 7)) ? (short)0x3F80 : (short)0; }
    const float ba = p.in[I_BA][ch], bx = p.in[I_BX][ch];
    const float lam = p.in[I_LAM][ch];
    const float c8 = -8.f * log1pf(expf(-lam)) * 1.4426950408889634f;
    float carry = 0.f;
    const int ksx = j >> 1;
    bf16x8 xa[2][4], ga[2];
    auto ldtile = [&](int T, bf16x8 (&x)[2][4], bf16x8 (&gq)[2]) {
#pragma unroll
        for (int mt = 0; mt < 2; ++mt) {
            int s = 32 * T + 16 * mt + col; if (s > NMETA + SEQ - 1) s = NMETA + SEQ - 1;
            const size_t row = seq_row(b, s);
#pragma unroll
            for (int ks = 0; ks < 4; ++ks) x[mt][ks] = *(const bf16x8*)(XC + row * DRNN + n * 128 + 32 * ks + 8 * grp);
            gq[mt] = *(const bf16x8*)(Z + row * NZ1 + n * 128 + 32 * ksx + 8 * grp);
        }
    };
    ldtile(0, xa, ga);
#pragma unroll 1
    for (int T = 0; T < 65; ++T) {
        bf16x8 xn[2][4], gn[2];
        ldtile(T + 1 < 65 ? T + 1 : T, xn, gn);
        f32x4 accA[2], accX[2], xb[2], gg[2];
#pragma unroll
        for (int mt = 0; mt < 2; ++mt) {
            f32x4 a = {0.f, 0.f, 0.f, 0.f}, x = {0.f, 0.f, 0.f, 0.f};
#pragma unroll
            for (int ks = 0; ks < 4; ++ks) { a = __builtin_amdgcn_mfma_f32_16x16x32_bf16(xa[mt][ks], bw[0][ks], a, 0, 0, 0); x = __builtin_amdgcn_mfma_f32_16x16x32_bf16(xa[mt][ks], bw[1][ks], x, 0, 0, 0); }
            accA[mt] = a; accX[mt] = x;
            const bf16x8 xsel = ksx == 0 ? xa[mt][0] : ksx == 1 ? xa[mt][1] : ksx == 2 ? xa[mt][2] : xa[mt][3];
            xb[mt] = __builtin_amdgcn_mfma_f32_16x16x32_bf16(xsel, ident, (f32x4){0.f, 0.f, 0.f, 0.f}, 0, 0, 0);
            gg[mt] = __builtin_amdgcn_mfma_f32_16x16x32_bf16(ga[mt], ident, (f32x4){0.f, 0.f, 0.f, 0.f}, 0, 0, 0);
        }
        float hl[2][4], Ac[2][4], Aex[2], hex[2], Atot[2], htot[2];
#pragma unroll
        for (int mt = 0; mt < 2; ++mt) {
            float ar = 1.f, hr = 0.f;
#pragma unroll
            for (int k = 0; k < 4; ++k) {
                const int s = 32 * T + 16 * mt + 4 * grp + k;
                const float rg = fast_sigmoid(accA[mt][k] + ba), ig = fast_sigmoid(accX[mt][k] + bx);
                float a = __builtin_amdgcn_exp2f(c8 * rg);
                float bt = __builtin_amdgcn_sqrtf(fmaxf(1.f - a * a, 0.f)) * (ig * xb[mt][k]);
                if (s >= NMETA + SEQ) { a = 1.f; bt = 0.f; }
                hr = a * hr + bt; ar = ar * a; hl[mt][k] = hr; Ac[mt][k] = ar;
            }
            float Ai = ar, hi_ = hr;
            { const float A1 = __shfl_up(Ai, 16), h1 = __shfl_up(hi_, 16); if (grp >= 1) { hi_ = Ai * h1 + hi_; Ai = Ai * A1; } }
            { const float A2 = __shfl_up(Ai, 32), h2 = __shfl_up(hi_, 32); if (grp >= 2) { hi_ = Ai * h2 + hi_; Ai = Ai * A2; } }
            const float Ae = __shfl_up(Ai, 16), he = __shfl_up(hi_, 16);
            Aex[mt] = grp >= 1 ? Ae : 1.f; hex[mt] = grp >= 1 ? he : 0.f;
            Atot[mt] = __shfl(Ai, 48 + col); htot[mt] = __shfl(hi_, 48 + col);
        }
#pragma unroll
        for (int mt = 0; mt < 2; ++mt) {
            const float cin = Aex[mt] * carry + hex[mt];
#pragma unroll
            for (int k = 0; k < 4; ++k) {
                const int s = 32 * T + 16 * mt + 4 * grp + k;
                const float h = hl[mt][k] + Ac[mt][k] * cin;
                if (s < NMETA + SEQ && (s >= NMETA || b == 0)) Y1[seq_row(b, s) * DRNN + ch] = f2bf(gg[mt][k] * h);
            }
            carry = Atot[mt] * carry + htot[mt];
        }
#pragma unroll
        for (int mt = 0; mt < 2; ++mt) { ga[mt] = gn[mt];
#pragma unroll
            for (int ks = 0; ks < 4; ++ks) xa[mt][ks] = xn[mt][ks]; }
    }
}
__device__ __forceinline__ void scan_phase(const Frame& F, const P& p) {
    const int gw = F.vcu * NWAVES + F.wave, NGW = F.G * NWAVES;
    for (int u = gw; u < 640 * 3; u += NGW) { if (u % 3) continue; const int id = u / 3; scan_unit(F, p, id / 80, (id % 80) / 8, id % 8); }
}
}
namespace s5 {
typedef float f32x16 __attribute__((ext_vector_type(16)));
constexpr size_t T_K = 19 * MiB, T_A = 19 * MiB + 512 * 1024, T_Q = 20 * MiB, T_P = 24 * MiB;
constexpr int L_U = 0, L_K = 65536, L_E = 81920, L_S = 114688;
__device__ __forceinline__ int crow(int r, int hi) { return (r & 3) + 8 * (r >> 2) + 4 * hi; }

struct Disc { float lrdt, lidt, ar, ai; float bbr[16], bbi[16]; };
__device__ __forceinline__ void disc(const P& p, int g, int lane, Disc& d) {
    const float dt = expf(p.in[I_LOGDT][g]);
    const float lr = fminf(p.in[I_LRE][g * 64 + lane], -1e-4f), li = p.in[I_LIM][g * 64 + lane];
    d.lrdt = lr * dt; d.lidt = li * dt;
    const float mag = expf(d.lrdt); d.ar = mag * cosf(d.lidt); d.ai = mag * sinf(d.lidt);
    const float den = lr * lr + li * li, nr = d.ar - 1.f, ni = d.ai;
    const float fr = (nr * lr + ni * li) / den, fi = (ni * lr - nr * li) / den;
#pragma unroll
    for (int h = 0; h < 16; ++h) { const float br = p.in[I_BRE][((size_t)g * 64 + lane) * 16 + h], bi = p.in[I_BIM][((size_t)g * 64 + lane) * 16 + h];
        d.bbr[h] = fr * br - fi * bi; d.bbi[h] = fr * bi + fi * br; }
}
__device__ __forceinline__ void table_item(const P& p, int g, int tau, LAS float* scr, int lane) {
    Disc d; disc(p, g, lane, d);
    const float mag = expf(d.lrdt * (float)tau); float sn, cs; sincosf(d.lidt * (float)tau, &sn, &cs);
    const float pr = mag * cs, pi = mag * sn;
    bf16* Kt = (bf16*)(p.ws + T_K); bf16* Qg = (bf16*)(p.ws + T_Q); bf16* Pg = (bf16*)(p.ws + T_P); float* A32 = (float*)(p.ws + T_A);
    if (tau == 32) { A32[(g * 64 + lane) * 2] = pr; A32[(g * 64 + lane) * 2 + 1] = pi; }
    if (tau >= 1) {
#pragma unroll
        for (int h = 0; h < 16; ++h) { const float cr = p.in[I_CRE][((size_t)g * 16 + h) * 64 + lane], ci = p.in[I_CIM][((size_t)g * 16 + h) * 64 + lane];
            bf16* row = Pg + ((size_t)g * 512 + (tau - 1) * 16 + h) * 128;
            row[lane] = f2bf(cr * pr - ci * pi); row[64 + lane] = f2bf(-(cr * pi + ci * pr)); }
    }
    if (tau <= 31) {
        float pbr[16], pbi[16];
#pragma unroll
        for (int h = 0; h < 16; ++h) { pbr[h] = pr * d.bbr[h] - pi * d.bbi[h]; pbi[h] = pr * d.bbi[h] + pi * d.bbr[h]; }
        bf16* qre = Qg + ((size_t)g * 128 + lane) * 512 + (31 - tau) * 16; bf16* qim = Qg + ((size_t)g * 128 + 64 + lane) * 512 + (31 - tau) * 16;
        store16bf(qre, pbr); store16bf(qim, pbi);
#pragma unroll
        for (int h = 0; h < 16; ++h) { scr[lane * 33 + h] = pbr[h]; scr[lane * 33 + 16 + h] = pbi[h]; }
        LDS_WAIT(); asm volatile("" ::: "memory");
        const int h = lane >> 2, hq = (lane & 3) * 4;
        float acc[4] = {0.f, 0.f, 0.f, 0.f};
        for (int pp = 0; pp < 64; ++pp) { const float cr = p.in[I_CRE][((size_t)g * 16 + h) * 64 + pp], ci = p.in[I_CIM][((size_t)g * 16 + h) * 64 + pp];
#pragma unroll
            for (int e = 0; e < 4; ++e) acc[e] += cr * scr[pp * 33 + hq + e] - ci * scr[pp * 33 + 16 + hq + e]; }
        bf16* kp = Kt + ((size_t)g * 32 + tau) * 256 + h * 16 + hq;
        *(unsigned long long*)kp = (unsigned long long)pk2(acc[0], acc[1]) | ((unsigned long long)pk2(acc[2], acc[3]) << 32);
        LDS_WAIT(); asm volatile("" ::: "memory");
    }
}

__device__ __forceinline__ int u_off(int token, int hbyte) { return ((token * 32 + hbyte) ^ (((token >> 5) & 15) << 4)); }
__device__ __forceinline__ int s_off(int c, int kbyte) { return ((c * 256 + kbyte) ^ ((c & 15) << 4)); }

__device__ __forceinline__ void s5_unit(const Frame& F, const P& p, LAS unsigned char* lds, int b, int g) {
    const bf16* Z = (const bf16*)(p.ws + WS_Z); bf16* YP = (bf16*)(p.ws + WS_YP);
    const bf16* Kt = (const bf16*)(p.ws + T_K) + (size_t)g * 32 * 256; const bf16* Qg = (const bf16*)(p.ws + T_Q) + (size_t)g * 128 * 512;
    const bf16* Pg = (const bf16*)(p.ws + T_P) + (size_t)g * 512 * 128; const float* A32 = (const float*)(p.ws + T_A) + (size_t)g * 128;
    const int tid = F.tid, lane = F.lane, wid = F.wave, r32 = lane & 31, hi = lane >> 5;
#pragma unroll
    for (int i = 0; i < 8; ++i) { const int id = tid + 512 * i, tok = id >> 1, half = id & 1;
        const v4u v = *(const v4u*)(Z + ((size_t)b * SEQ + tok) * NZ0 + g * 16 + half * 8);
        *(LAS v4u*)(lds + L_U + u_off(tok, half * 16)) = v; }
#pragma unroll
    for (int i = 0; i < 2; ++i) { const int id = tid + 512 * i; *(LAS v4u*)(lds + L_K + id * 16) = *(const v4u*)(Kt + id * 8); }
    LAS float* msc = (LAS float*)(lds + L_E);
    if (wid == 0) {
        Disc d; disc(p, g, lane, d);
        { const int s = lane >> 2, h4 = (lane & 3) * 4; const unsigned long long uu = *(const unsigned long long*)(Z + (size_t)(MX + s) * NZ0 + g * 16 + h4);
#pragma unroll
          for (int e = 0; e < 4; ++e) msc[s * 16 + h4 + e] = bf2f((bf16)((uu >> (16 * e)) & 0xffffu)); }
        if (b == 0) for (int i = lane; i < 1024; i += 64) { msc[512 + i] = p.in[I_CRE][(size_t)g * 1024 + i]; msc[512 + 1024 + i] = p.in[I_CIM][(size_t)g * 1024 + i]; }
        LDS_WAIT(); asm volatile("" ::: "memory");
        float hr = 0.f, hm = 0.f;
        for (int s = 0; s < NMETA; ++s) {
            float bur = 0.f, bui = 0.f;
#pragma unroll
            for (int h = 0; h < 16; ++h) { const float u = msc[s * 16 + h]; bur += u * d.bbr[h]; bui += u * d.bbi[h]; }
            const float nhr = d.ar * hr - d.ai * hm + bur, nhi = d.ar * hm + d.ai * hr + bui; hr = nhr; hm = nhi;
            if (b == 0) {
                msc[256 + lane] = hr; msc[320 + lane] = hm;
                LDS_WAIT(); asm volatile("" ::: "memory");
                const int h = lane >> 2, q = lane & 3; float y = 0.f;
                for (int pp = q * 16; pp < q * 16 + 16; ++pp) y += msc[256 + pp] * msc[512 + h * 64 + pp] - msc[320 + pp] * msc[512 + 1024 + h * 64 + pp];
                y += __shfl_xor(y, 1); y += __shfl_xor(y, 2);
                if (q == 0) { y += p.in[I_S5D][g * 16 + h] * msc[s * 16 + h]; YP[(size_t)(MX + s) * 512 + g * 16 + h] = f2bf(gelu_tanh(y)); }
                LDS_WAIT(); asm volatile("" ::: "memory");
            }
        }
        *(LAS bf16*)(lds + L_S + s_off(0, lane * 2)) = f2bf(hr); *(LAS bf16*)(lds + L_S + s_off(0, (64 + lane) * 2)) = f2bf(hm);
        msc[256 + lane] = hr; msc[320 + lane] = hm;
    }
    __syncthreads();
    float s0r = 0.f, s0i = 0.f;
    if (wid == 0) { s0r = msc[256 + lane]; s0i = msc[320 + lane]; }
    __syncthreads();
    {
        const int mt = wid & 3, nt = wid >> 2, c = 32 * nt + r32;
        f32x16 acc = f32x16{};
        const bf16* qa = Qg + (size_t)(32 * mt + r32) * 512 + hi * 8;
#pragma unroll
        for (int kh = 0; kh < 2; ++kh) {
            bf16x8 af[16];
#pragma unroll
            for (int k2 = 0; k2 < 16; ++k2) af[k2] = *(const bf16x8*)(qa + (16 * kh + k2) * 16);
#pragma unroll
            for (int k2 = 0; k2 < 16; ++k2) { const int ks = 16 * kh + k2;
                const bf16x8 bq = *(const LAS bf16x8*)(lds + L_U + u_off(32 * c + ks, hi * 16));
                acc = __builtin_amdgcn_mfma_f32_32x32x16_bf16(af[k2], bq, acc, 0, 0, 0); }
        }
        LAS float* E = (LAS float*)(lds + L_E);
#pragma unroll
        for (int r = 0; r < 16; ++r) E[c * 128 + 32 * mt + crow(r, hi)] = acc[r];
    }
    __syncthreads();
    if (wid == 0) {
        const float a32r = A32[lane * 2], a32i = A32[lane * 2 + 1];
        const LAS float* E = (const LAS float*)(lds + L_E);
        float sr = s0r, si = s0i;
        for (int c = 0; c < 63; ++c) {
            const float er = E[c * 128 + lane], ei = E[c * 128 + 64 + lane];
            const float nr = a32r * sr - a32i * si + er, ni = a32r * si + a32i * sr + ei; sr = nr; si = ni;
            *(LAS bf16*)(lds + L_S + s_off(c + 1, lane * 2)) = f2bf(sr); *(LAS bf16*)(lds + L_S + s_off(c + 1, (64 + lane) * 2)) = f2bf(si);
        }
    }
    __syncthreads();
#pragma unroll 1
    for (int q4 = 0; q4 < 4; ++q4) {
        const int i = (q4 & 1) ? 15 - wid : wid, nt = q4 >> 1, c = 32 * nt + r32;
        const int t = 2 * i + (r32 >> 4), h = r32 & 15;
        f32x16 acc = f32x16{};
        const bf16* pa = Pg + (size_t)(32 * i + r32) * 128 + hi * 8;
#pragma unroll
        for (int ks = 0; ks < 8; ++ks) {
            const bf16x8 a = *(const bf16x8*)(pa + ks * 16);
            const bf16x8 bq = *(const LAS bf16x8*)(lds + L_S + s_off(c, ks * 32 + hi * 16));
            acc = __builtin_amdgcn_mfma_f32_32x32x16_bf16(a, bq, acc, 0, 0, 0);
        }
#pragma unroll 2
        for (int s = 0; s <= 2 * i + 1; ++s) {
            const int tau = t - s;
            bf16x8 a = *(const LAS bf16x8*)(lds + L_K + ((tau < 0 ? 0 : tau) * 256 + h * 16 + hi * 8) * 2);
            if (tau < 0) a = (bf16x8){0, 0, 0, 0, 0, 0, 0, 0};
            const bf16x8 bq = *(const LAS bf16x8*)(lds + L_U + u_off(32 * c + s, hi * 16));
            acc = __builtin_amdgcn_mfma_f32_32x32x16_bf16(a, bq, acc, 0, 0, 0);
        }
#pragma unroll
        for (int rq = 0; rq < 4; ++rq) {
            const int tt = 2 * i + (rq >> 1), h0 = 8 * (rq & 1) + 4 * hi, tok = 32 * c + tt;
            const unsigned long long uu = *(const LAS unsigned long long*)(lds + L_U + u_off(tok, h0 * 2));
            const pg8::f32x4 dd = *(const pg8::f32x4*)(p.in[I_S5D] + g * 16 + h0);
            float y[4];
#pragma unroll
            for (int e = 0; e < 4; ++e) { const float u = bf2f((bf16)((uu >> (16 * e)) & 0xffffu)); y[e] = fast_gelu(acc[4 * rq + e] + dd[e] * u); }
            *(unsigned long long*)(YP + ((size_t)b * SEQ + tok) * 512 + g * 16 + h0) = (unsigned long long)pk2(y[0], y[1]) | ((unsigned long long)pk2(y[2], y[3]) << 32);
        }
    }
    __syncthreads();
}
__device__ __forceinline__ void s5_phase(const Frame& F, const P& p, LAS unsigned char* lds) {
#pragma unroll 1
    for (int u = F.vcu; u < 256; u += F.G) s5_unit(F, p, lds, u >> 5, u & 31);
}
}

typedef ArgsF Args;
typedef __attribute__((address_space(4))) const Args CArgs;
__device__ __forceinline__ void load_p(P& p, CArgs* q) {
    asm volatile("" : "+s"(q));
#pragma unroll
    for (int i = 0; i < 50; ++i) p.in[i] = q->p.in[i];
    p.out = q->p.out; p.ws = q->p.ws;
}

#ifndef PH_MASK
#define PH_MASK 0xFFFFFFFFu
#endif
#define IN(k) (((PH_MASK >> (k)) & 1u) && lo <= (k) && (k) < hi)
#define SEAM(k) do { if (IN(k) && IN((k) + 1)) xcd_barrier(bar); } while (0)
#ifndef REP_MASK
#define REP_MASK 0u
#endif
#ifndef REP_N
#define REP_N 2
#endif
#define REPS(k) for (int rep_ = 0; rep_ < ((((REP_MASK) >> (k)) & 1u) ? REP_N : 1); ++rep_, ((((REP_MASK) >> (k)) & 1u) && rep_ < REP_N ? xcd_barrier(bar) : (void)0))
template <int L> __device__ __forceinline__ void moe_gemm_phases(const Frame& F, CArgs* ap0, unsigned* ctl, volatile LAS unsigned* MISC, const XcdBarrier& bar, int lo, int hi) {
        const int ph = L ? 15 : 7;
        if (IN(ph)) REPS(ph) {
            P p; load_p(p, ap0);
            volatile LAS int* tp = (volatile LAS int*)(MISC + 16);
            const int* cnt = (const int*)ctl + (L ? CW_CNT1 : CW_CNT0);
            const int tiles = moe_prefix(cnt, tp, F.tid);
            MoeOrder<true, 4, 1024, 1024> S{(const char*)(p.ws + WS_HB), (const char*)(p.ws + (L ? WS_MOE1 : WS_MOE0) + MOE_WGU), (const int*)(p.ws + WS_ROUTE), cnt, tp, F.G, F.vcu, tiles * 4};
            FEpiMoe1 E{(bf16*)(p.ws + WS_YM)};
            pg8::gemm_phase<FEpiMoe1, MoeOrder<true, 4, 1024, 1024>, true>(F.lds, 1024, S, E);
        }
        SEAM(ph);
        if (IN(ph + 1)) REPS(ph + 1) {
            P p; load_p(p, ap0);
            volatile LAS int* tp = (volatile LAS int*)(MISC + 16);
            const int* cnt = (const int*)ctl + (L ? CW_CNT1 : CW_CNT0);
            const int tiles = moe_prefix(cnt, tp, F.tid);
            MoeOrder<false, 4, 512, 1024> S{(const char*)(p.ws + WS_YM), (const char*)(p.ws + (L ? WS_MOE1 : WS_MOE0) + MOE_WD), (const int*)(p.ws + WS_ROUTE), cnt, tp, F.G, F.vcu, tiles * 4};
            FEpiMoe2 E{(bf16*)(p.ws + WS_Z), (const int*)(p.ws + WS_ROUTE), (const float*)(p.ws + WS_GATE)};
            pg8::gemm_phase<FEpiMoe2, MoeOrder<false, 4, 512, 1024>, true>(F.lds, 512, S, E);
        }
        SEAM(ph + 1);
}
__global__ void __launch_bounds__(NWAVES * 64, 2) mk(Args args) {
    extern __shared__ __attribute__((aligned(16))) unsigned char lds_raw[];
    CArgs* ap0 = (CArgs*)__builtin_amdgcn_kernarg_segment_ptr();
    Frame F;
    F.lds = (LAS unsigned char*)lds_raw;
    F.tid = threadIdx.x; F.lane = F.tid & 63; F.wave = __builtin_amdgcn_readfirstlane(F.tid >> 6);
    F.G = gridDim.x; { const int bx = blockIdx.x; F.vcu = (F.G % 8 == 0) ? (bx % 8) * (F.G / 8) + bx / 8 : bx; }
    volatile LAS unsigned* MISC = (volatile LAS unsigned*)(F.lds + MISC_OFF);
    for (int u = F.tid; u < (LDS_BYTES - RING_BYTES) / 4; u += NWAVES * 64) ((LAS unsigned*)(F.lds + RING_BYTES))[u] = 0u;
    __syncthreads();
    unsigned* ctl = (unsigned*)(ap0->p.ws + WS_CTL);
    const bool multi = (ap0->ph_hi - ap0->ph_lo) > 1;
    XcdBarrier bar; bar.bar = ctl + CW_BAR + ap0->li * XCD_BAR_WORDS; bar.x = 0; bar.st = nullptr;
    if (multi) bar = xcd_barrier_post(ctl + CW_BAR + ap0->li * XCD_BAR_WORDS, MISC + 8);
    const int lo = ap0->ph_lo, hi = ap0->ph_hi;
    const int gw = F.vcu * NWAVES + F.wave, NGW = F.G * NWAVES;

#ifdef EXTRA_BARS
    if (multi) for (int eb = 0; eb < EXTRA_BARS; ++eb) xcd_barrier(bar);
#endif
    if (IN(0)) REPS(0) {
        P p; load_p(p, ap0);
        LAS float* scr = (LAS float*)(F.lds + F.wave * 16384);
        { CArgsF* q = ap0; asm volatile("" : "+s"(q)); for (int it = gw; it < CI_SMALL + CI_MOE; it += NGW) cvt_item(q, it, scr, F.lane); }
        for (int it = gw; it < 32 * 33; it += NGW) s5::table_item(p, it / 33, it % 33, scr, F.lane);
        router_table(p, gw * 64 + F.lane, NGW * 64);
        bf16* H0b = (bf16*)(p.ws + WS_R1);
        for (int r = gw; r < MR; r += NGW) {
            const float* src = r < MX ? p.in[I_X] + (size_t)r * D : p.in[I_META] + (size_t)(r - MX) * D;
#pragma unroll
            for (int j = 0; j < 4; ++j) { const f32x4 v = *(const f32x4*)(src + j * 256 + F.lane * 4);
                *(unsigned long long*)(H0b + (size_t)r * D + j * 256 + F.lane * 4) = (unsigned long long)pk2(v[0], v[1]) | ((unsigned long long)pk2(v[2], v[3]) << 32); }
        }
    }
    SEAM(0);
    if (IN(1)) REPS(1) {
        P p; load_p(p, ap0);
        pg8::DenseOrder S; S.init(p.ws + WS_R1, p.ws + WB_WIN0, MX, NZ0, D, F.G, (int)blockIdx.x);
        FEpiZ0 E{(bf16*)(p.ws + WS_Z)};
        pg8::gemm_phase<FEpiZ0, pg8::DenseOrder, true>(F.lds, D, S, E);
        meta_gemm(F, p, (const bf16*)(p.ws + WS_R1) + (size_t)MX * D, D, (const bf16*)(p.ws + WB_WIN0), NZ0, D, EZ0{});
    }
    SEAM(1);

    if (IN(2)) REPS(2) { P p; load_p(p, ap0); s5::s5_phase(F, p, F.lds); }
    if (IN(3)) REPS(3) { P p; load_p(p, ap0); att::attn_phase(F, p, F.lds); }
    SEAM(3);
    if (IN(4)) REPS(4) {
        P p; load_p(p, ap0);
        pg8::DenseOrder S; S.init(p.ws + WS_YP, p.ws + WB_WGLU, MX, 512, 512, F.G, (int)blockIdx.x);
        FEpiGLU E{(const bf16*)(p.ws + WS_YP), (bf16*)(p.ws + WS_YM), p.in[I_BGLU]};
        pg8::gemm_phase<FEpiGLU, pg8::DenseOrder, true>(F.lds, 512, S, E);
        meta_gemm(F, p, (const bf16*)(p.ws + WS_YP) + (size_t)MX * 512, 512, (const bf16*)(p.ws + WB_WGLU), 512, 512, EGLU{});
    }
    SEAM(4);
    if (IN(5)) REPS(5) {
        P p; load_p(p, ap0);
        pg8::DenseOrder S; S.init(p.ws + WS_YM, p.ws + WB_WOUT0, MX, D, D, F.G, (int)blockIdx.x);
        FEpiOut0 E{p.in[I_X], (bf16*)(p.ws + WS_R1)};
        pg8::gemm_phase<FEpiOut0, pg8::DenseOrder, true>(F.lds, D, S, E);
        meta_gemm(F, p, (const bf16*)(p.ws + WS_YM) + (size_t)MX * D, D, (const bf16*)(p.ws + WB_WOUT0), D, D, EOUT0{});
    }
    SEAM(5);
    if (IN(6)) { P p; load_p(p, ap0); router_phase<0>(F, p, gw, NGW, F.lds);
#ifdef ROUTER_FULL2
        xcd_barrier(bar); if (blockIdx.x == 0 && F.tid < 32) ((int*)ctl)[CW_CNT0 + CNT_IDX(F.tid)] = 0; xcd_barrier(bar); router_phase<0>(F, p, gw, NGW, F.lds);
#endif
    }
    SEAM(6);
    moe_gemm_phases<0>(F, ap0, ctl, MISC, bar, lo, hi);
    if (IN(9)) { P p; load_p(p, ap0); combine_phase<0>(F, p, gw, NGW); }
    SEAM(9);
    if (IN(10)) REPS(10) {
        P p; load_p(p, ap0);
        pg8::DenseOrder S; S.init(p.ws + WS_HB, p.ws + WB_WIN1, MX, NZ1, D, F.G, (int)blockIdx.x);
        FEpiZ1 E{(bf16*)(p.ws + WS_Z)};
        pg8::gemm_phase<FEpiZ1, pg8::DenseOrder, true>(F.lds, D, S, E);
        meta_gemm(F, p, (const bf16*)(p.ws + WS_HB) + (size_t)MX * D, D, (const bf16*)(p.ws + WB_WIN1), NZ1, D, EZ1{});
    }
    SEAM(10);
    if (IN(11)) REPS(11) { P p; load_p(p, ap0); lru::conv_phase(F, p); }
    SEAM(11);
    if (IN(12)) REPS(12) { P p; load_p(p, ap0);
        const bool scanner = (gw % 3 == 0) && gw < 1920;
        if (scanner) lru::scan_phase(F, p);
        else { CArgsF* q = ap0; asm volatile("" : "+s"(q)); LAS float* scr = (LAS float*)(F.lds + F.wave * 16384);
            const int rank = gw < 1920 ? gw - (gw / 3 + 1) : 1280 + (gw - 1920);
            for (int it = CI_SMALL + CI_MOE + rank; it < CI_TOTAL; it += NGW - 640) cvt_item(q, it, scr, F.lane); }
    }
    SEAM(12);
    if (IN(13)) REPS(13) {
        P p; load_p(p, ap0);
        pg8::DenseOrder S; S.init(p.ws + WS_YM, p.ws + WB_WOUT1, MX, D, DRNN, F.G, (int)blockIdx.x);
        FEpiOut1 E{(const bf16*)(p.ws + WS_HB), (bf16*)(p.ws + WS_R1)};
        pg8::gemm_phase<FEpiOut1, pg8::DenseOrder, true>(F.lds, DRNN, S, E);
        meta_gemm(F, p, (const bf16*)(p.ws + WS_YM) + (size_t)MX * DRNN, DRNN, (const bf16*)(p.ws + WB_WOUT1), D, DRNN, EOUT1{});
    }
    SEAM(13);
    if (IN(14)) { P p; load_p(p, ap0); router_phase<1>(F, p, gw, NGW, F.lds); }
    SEAM(14);
    moe_gemm_phases<1>(F, ap0, ctl, MISC, bar, lo, hi);
    if (IN(17)) { P p; load_p(p, ap0); combine_phase<1>(F, p, gw, NGW);
#ifdef COMBINE2
        xcd_barrier(bar); combine_phase<1>(F, p, gw, NGW);
#endif
    }

}

static int g_grid = 0;
static void launch_mk(const P& p, int lo, int hi, int li, hipStream_t stream) {
    Args a{}; a.p = p; a.ph_lo = lo; a.ph_hi = hi; a.li = li; a.pad = 0;
    hipLaunchKernelGGL(mk, dim3(g_grid), dim3(NWAVES * 64), LDS_BYTES, stream, a);
}
extern "C" void kernel_launch(void* const* d_in, const int* in_sizes, int n_in, void* d_out, int out_size, void* d_ws, size_t ws_size, hipStream_t stream) {
    if (n_in != 50 || ws_size < WS_END) { fprintf(stderr, "kernel_launch: unexpected n_in %d or ws %zu\n", n_in, ws_size); return; }
    if (g_grid == 0) {
        int dev = 0, cus = 0, per_cu = 0;
        (void)hipGetDevice(&dev); (void)hipDeviceGetAttribute(&cus, hipDeviceAttributeMultiprocessorCount, dev);
        if (hipFuncSetAttribute((const void*)mk, hipFuncAttributeMaxDynamicSharedMemorySize, LDS_BYTES) != hipSuccess) { fprintf(stderr, "hipFuncSetAttribute failed\n"); g_grid = -1; return; }
        if (hipOccupancyMaxActiveBlocksPerMultiprocessor(&per_cu, (const void*)mk, NWAVES * 64, LDS_BYTES) != hipSuccess || per_cu < 1) { fprintf(stderr, "occupancy query: %d\n", per_cu); }
        (void)hipGetLastError();
        g_grid = cus > 0 ? cus : 256;
    }
    if (g_grid < 0) return;
    P p{};
    for (int i = 0; i < 50; ++i) p.in[i] = (const float*)d_in[i];
    p.out = (float*)d_out; p.ws = (unsigned char*)d_ws;
    (void)hipMemsetAsync((char*)d_ws + WS_CTL, 0, 1 * MiB, stream);
    launch_mk(p, 0, 18, 0, stream);
}
```

```cpp
#include <hip/hip_runtime.h>
#include <cstdint>
#include <cstdio>
#include <cmath>

constexpr int D = 1024, NB = 8, SEQ = 2048, NMETA = 16;
constexpr int MX = NB * SEQ;
constexpr int MR = MX + NMETA;
constexpr int MA = MX + 256;
constexpr int NZ0 = 2048, NZ1 = 2560, DRNN = 1280;
constexpr float ALPHA = 1.4142135623730951f;
constexpr float LN_EPS = 1e-5f;
constexpr float QSCALE = 0.125f * 1.4426950408889634f;
constexpr float LAM_INIT = 0.2f;
constexpr int NE = 32;
constexpr int LIST_CAP = MR;
constexpr int SLOT_CAP = 40960;

typedef unsigned short bf16;
__device__ __forceinline__ float bf2f(bf16 v) { return __uint_as_float(((unsigned)v) << 16); }
__device__ __forceinline__ bf16 f2bf(float f) { unsigned u = __float_as_uint(f); return (bf16)((u + 0x7fffu + ((u >> 16) & 1u)) >> 16); }

constexpr size_t MiB = 1u << 20;
constexpr size_t WS_CTL = 0;
constexpr size_t WS_ROUTE = 1 * MiB;
constexpr size_t WS_GATE = WS_ROUTE + 2 * MiB + 512 * 1024;
constexpr size_t WS_EBASE = WS_ROUTE + 3 * MiB - 1024;
constexpr size_t WS_WB = 4 * MiB;
constexpr size_t WS_MOE0 = 28 * MiB;
constexpr size_t WS_MOE1 = 124 * MiB;
constexpr size_t WS_R1 = 220 * MiB;
constexpr size_t WS_Z = 253 * MiB;
constexpr size_t WS_YP = 335 * MiB;
constexpr size_t WS_YM = 352 * MiB;
constexpr size_t WS_HB = 393 * MiB;
constexpr size_t WS_END = 426 * MiB;
constexpr int CW_CNT0 = 32768, CW_CNT1 = 32768 + 2048;
#define CNT_IDX(e) ((e) * 64)

struct P {
    const float* in[50];
    float* out;
    unsigned char* ws;
};
enum { I_X = 0, I_META, I_L0LN1G, I_L0LN1B, I_L0WIN, I_LRE, I_LIM, I_LOGDT, I_BRE, I_BIM, I_CRE, I_CIM, I_S5D, I_WGLU, I_BGLU,
       I_LQ1, I_LK1, I_LQ2, I_LK2, I_SUBLN, I_L0WOUT, I_L0LN2G, I_L0LN2B, I_M0WC, I_M0BC, I_M0WF, I_M0BF, I_M0WG, I_M0WU, I_M0WD,
       I_L1LN1G, I_L1LN1B, I_L1WIN, I_CONVW, I_CONVB, I_WA, I_BA, I_WX, I_BX, I_LAM, I_L1WOUT, I_L1LN2G, I_L1LN2B,
       I_M1WC, I_M1BC, I_M1WF, I_M1BF, I_M1WG, I_M1WU, I_M1WD };

__device__ __forceinline__ float gelu_tanh(float x) {
    const float c = 0.7978845608028654f;
    float u = c * (x + 0.044715f * x * x * x);
    return 0.5f * x * (1.f + tanhf(u));
}
__device__ __forceinline__ float sigmoidf_(float x) { return 1.f / (1.f + expf(-x)); }
__device__ __forceinline__ float wave_sum(float v) {
#pragma unroll
    for (int o = 1; o < 64; o <<= 1) v += __shfl_xor(v, o);
    return v;
}
__device__ __forceinline__ float wave_max(float v) {
#pragma unroll
    for (int o = 1; o < 64; o <<= 1) v = fmaxf(v, __shfl_xor(v, o));
    return v;
}

__global__ void n_h0(P p) {
    bf16* H0b = (bf16*)(p.ws + WS_R1);
    size_t i = (size_t)blockIdx.x * blockDim.x + threadIdx.x;
    if (i >= (size_t)MR * D) return;
    size_t r = i / D, c = i % D;
    float v = r < MX ? p.in[I_X][i] : p.in[I_META][(r - MX) * D + c];
    H0b[i] = f2bf(v);
}

template <class E, bool DUAL>
__global__ void __launch_bounds__(256) n_gemm(P p, E e) {
    __shared__ float As[16][65];
    __shared__ float Ws[16][65];
    __shared__ float Ws2[DUAL ? 16 : 1][65];
    int M, N, K, lda, ldw; const bf16* A; const float* W; const float* W2;
    if (!e.setup(p, blockIdx.z, M, N, K, A, lda, W, W2, ldw)) return;
    const int m0 = blockIdx.y * 64, n0 = blockIdx.x * 64;
    if (m0 >= M || n0 >= N) return;
    const int tx = threadIdx.x & 15, ty = threadIdx.x >> 4;
    float acc[4][4] = {}, acc2[4][4] = {};
    for (int k0 = 0; k0 < K; k0 += 16) {
        for (int i = threadIdx.x; i < 64 * 16; i += 256) {
            int mm = i >> 4, kk = i & 15; int m = m0 + mm;
            float v = 0.f;
            if (m < M) { long ar = e.arow(p, blockIdx.z, m); v = bf2f(A[(size_t)ar * lda + k0 + kk]); }
            As[kk][mm] = v;
        }
        for (int i = threadIdx.x; i < 64 * 16; i += 256) {
            int kk = i >> 6, nn = i & 63;
            Ws[kk][nn] = W[(size_t)(k0 + kk) * ldw + n0 + nn];
            if (DUAL) Ws2[kk][nn] = W2[(size_t)(k0 + kk) * ldw + n0 + nn];
        }
        __syncthreads();
#pragma unroll
        for (int kk = 0; kk < 16; ++kk) {
            float a[4], b[4], b2[4];
#pragma unroll
            for (int i = 0; i < 4; ++i) { a[i] = As[kk][ty * 4 + i]; b[i] = Ws[kk][tx * 4 + i]; b2[i] = DUAL ? Ws2[kk][tx * 4 + i] : 0.f; }
#pragma unroll
            for (int i = 0; i < 4; ++i)
#pragma unroll
                for (int j = 0; j < 4; ++j) { acc[i][j] += a[i] * b[j]; if (DUAL) acc2[i][j] += a[i] * b2[j]; }
        }
        __syncthreads();
    }
#pragma unroll
    for (int i = 0; i < 4; ++i)
#pragma unroll
        for (int j = 0; j < 4; ++j) {
            int m = m0 + ty * 4 + i, n = n0 + tx * 4 + j;
            if (m < M) e.store(p, blockIdx.z, m, n, acc[i][j], acc2[i][j]);
        }
}

struct EZ0 {
    __device__ bool setup(const P& p, int z, int& M, int& N, int& K, const bf16*& A, int& lda, const float*& W, const float*& W2, int& ldw) const {
        M = MR; N = NZ0; K = D; A = (const bf16*)(p.ws + WS_R1); lda = D; W = p.in[I_L0WIN]; W2 = nullptr; ldw = NZ0; return true; }
    __device__ long arow(const P&, int, int m) const { return m; }
    __device__ void store(const P& p, int, int m, int n, float v, float) const {
        bf16* Z = (bf16*)(p.ws + WS_Z); if (n >= 512 && n < 1024) v *= QSCALE; Z[(size_t)m * NZ0 + n] = f2bf(v); }
};
struct EGLU {
    __device__ bool setup(const P& p, int z, int& M, int& N, int& K, const bf16*& A, int& lda, const float*& W, const float*& W2, int& ldw) const {
        M = MR; N = 512; K = 512; A = (const bf16*)(p.ws + WS_YP); lda = 512; W = p.in[I_WGLU]; W2 = nullptr; ldw = 512; return true; }
    __device__ long arow(const P&, int, int m) const { return m; }
    __device__ void store(const P& p, int, int m, int n, float v, float) const {
        const bf16* YP = (const bf16*)(p.ws + WS_YP); bf16* YM = (bf16*)(p.ws + WS_YM);
        float y = bf2f(YP[(size_t)m * 512 + n]); YM[(size_t)m * D + n] = f2bf(y * sigmoidf_(v + p.in[I_BGLU][n])); }
};
struct EOUT0 {
    __device__ bool setup(const P& p, int z, int& M, int& N, int& K, const bf16*& A, int& lda, const float*& W, const float*& W2, int& ldw) const {
        M = MR; N = D; K = D; A = (const bf16*)(p.ws + WS_YM); lda = D; W = p.in[I_L0WOUT]; W2 = nullptr; ldw = D; return true; }
    __device__ long arow(const P&, int, int m) const { return m; }
    __device__ void store(const P& p, int, int m, int n, float v, float) const {
        bf16* R1 = (bf16*)(p.ws + WS_R1);
        float h0 = m < MX ? p.in[I_X][(size_t)m * D + n] : p.in[I_META][(size_t)(m - MX) * D + n];
        R1[(size_t)m * D + n] = f2bf(ALPHA * h0 + v); }
};
template <int L> struct EMOE1 {
    __device__ bool setup(const P& p, int z, int& M, int& N, int& K, const bf16*& A, int& lda, const float*& W, const float*& W2, int& ldw) const {
        const int* cnt = (const int*)(p.ws + WS_CTL) + (L ? CW_CNT1 : CW_CNT0);
        M = cnt[CNT_IDX(z)]; N = 512; K = D; A = (const bf16*)(p.ws + WS_HB); lda = D;
        W = p.in[L ? I_M1WG : I_M0WG] + (size_t)z * D * 512; W2 = p.in[L ? I_M1WU : I_M0WU] + (size_t)z * D * 512; ldw = 512; return M > 0; }
    __device__ long arow(const P& p, int z, int m) const { const int* list = (const int*)(p.ws + WS_ROUTE); return list[(size_t)z * LIST_CAP + m] >> 1; }
    __device__ void store(const P& p, int z, int m, int n, float g, float u) const {
        const int* ebase = (const int*)(p.ws + WS_EBASE);
        bf16* HID = (bf16*)(p.ws + WS_YM);
        float s = g / (1.f + expf(-g));
        HID[(size_t)(ebase[z] + m) * 512 + n] = f2bf(s * u); }
};
template <int L> struct EMOE2 {
    __device__ bool setup(const P& p, int z, int& M, int& N, int& K, const bf16*& A, int& lda, const float*& W, const float*& W2, int& ldw) const {
        const int* cnt = (const int*)(p.ws + WS_CTL) + (L ? CW_CNT1 : CW_CNT0);
        M = cnt[CNT_IDX(z)]; N = D; K = 512; A = (const bf16*)(p.ws + WS_YM); lda = 512;
        W = p.in[L ? I_M1WD : I_M0WD] + (size_t)z * 512 * D; W2 = nullptr; ldw = D; return M > 0; }
    __device__ long arow(const P& p, int z, int m) const { const int* ebase = (const int*)(p.ws + WS_EBASE); return ebase[z] + m; }
    __device__ void store(const P& p, int z, int m, int n, float v, float) const {
        const int* list = (const int*)(p.ws + WS_ROUTE); const float* gate = (const float*)(p.ws + WS_GATE);
        int asg = list[(size_t)z * LIST_CAP + m];
        bf16* Y2 = (bf16*)(p.ws + WS_Z);
        Y2[(size_t)asg * D + n] = f2bf(v * gate[asg]); }
};
struct EZ1 {
    __device__ bool setup(const P& p, int z, int& M, int& N, int& K, const bf16*& A, int& lda, const float*& W, const float*& W2, int& ldw) const {
        M = MR; N = NZ1; K = D; A = (const bf16*)(p.ws + WS_HB); lda = D; W = p.in[I_L1WIN]; W2 = nullptr; ldw = NZ1; return true; }
    __device__ long arow(const P&, int, int m) const { return m; }
    __device__ void store(const P& p, int, int m, int n, float v, float) const {
        bf16* Z = (bf16*)(p.ws + WS_Z);
        if (n < DRNN) Z[(size_t)m * NZ1 + n] = f2bf(gelu_tanh(v)); else Z[(size_t)m * NZ1 + n] = f2bf(v); }
};
struct EOUT1 {
    __device__ bool setup(const P& p, int z, int& M, int& N, int& K, const bf16*& A, int& lda, const float*& W, const float*& W2, int& ldw) const {
        M = MR; N = D; K = DRNN; A = (const bf16*)(p.ws + WS_YM); lda = DRNN; W = p.in[I_L1WOUT]; W2 = nullptr; ldw = D; return true; }
    __device__ long arow(const P&, int, int m) const { return m; }
    __device__ void store(const P& p, int, int m, int n, float v, float) const {
        bf16* R1 = (bf16*)(p.ws + WS_R1); const bf16* Hb = (const bf16*)(p.ws + WS_HB);
        R1[(size_t)m * D + n] = f2bf(ALPHA * bf2f(Hb[(size_t)m * D + n]) + v); }
};

__global__ void __launch_bounds__(64) n_s5(P p) {
    const int b = blockIdx.x >> 5, g = blockIdx.x & 31, lane = threadIdx.x;
    const bf16* Z = (const bf16*)(p.ws + WS_Z); bf16* YP = (bf16*)(p.ws + WS_YP);
    __shared__ float su[16], shr[64], shi[64], scre[16][64], scim[16][64];
    for (int i = lane; i < 1024; i += 64) { scre[i >> 6][i & 63] = p.in[I_CRE][(size_t)g * 1024 + i]; scim[i >> 6][i & 63] = p.in[I_CIM][(size_t)g * 1024 + i]; }
    const float dt = expf(p.in[I_LOGDT][g]);
    const float lr = fminf(p.in[I_LRE][g * 64 + lane], -1e-4f), li = p.in[I_LIM][g * 64 + lane];
    const float mag = expf(lr * dt), ar = mag * cosf(li * dt), ai = mag * sinf(li * dt);
    const float den = lr * lr + li * li, nr = ar - 1.f, ni = ai;
    const float fr = (nr * lr + ni * li) / den, fi = (ni * lr - nr * li) / den;
    float bbr[16], bbi[16];
#pragma unroll
    for (int h = 0; h < 16; ++h) { float br = p.in[I_BRE][((size_t)g * 64 + lane) * 16 + h], bi = p.in[I_BIM][((size_t)g * 64 + lane) * 16 + h];
        bbr[h] = fr * br - fi * bi; bbi[h] = fr * bi + fi * br; }
    float hr = 0.f, hi = 0.f;
    __syncthreads();
    for (int s = 0; s < NMETA + SEQ; ++s) {
        const size_t row = s < NMETA ? (size_t)(MX + s) : (size_t)b * SEQ + (s - NMETA);
        if (lane < 16) su[lane] = bf2f(Z[row * NZ0 + g * 16 + lane]);
        __syncthreads();
        float bur = 0.f, bui = 0.f;
#pragma unroll
        for (int h = 0; h < 16; ++h) { bur += su[h] * bbr[h]; bui += su[h] * bbi[h]; }
        const float nhr = ar * hr - ai * hi + bur, nhi = ar * hi + ai * hr + bui;
        hr = nhr; hi = nhi; shr[lane] = hr; shi[lane] = hi;
        __syncthreads();
        const int h = lane >> 2, q = lane & 3;
        float y = 0.f;
        for (int pp = q * 16; pp < q * 16 + 16; ++pp) y += shr[pp] * scre[h][pp] - shi[pp] * scim[h][pp];
        y += __shfl_xor(y, 1); y += __shfl_xor(y, 2);
        if (q == 0 && (s >= NMETA || b == 0)) {
            y += p.in[I_S5D][g * 16 + h] * su[h];
            YP[row * 512 + g * 16 + h] = f2bf(gelu_tanh(y));
        }
        __syncthreads();
    }
}

__global__ void __launch_bounds__(256) n_attn(P p) {
    const int r = blockIdx.x, h = threadIdx.x >> 6, lane = threadIdx.x & 63;
    const bf16* Z = (const bf16*)(p.ws + WS_Z); bf16* YM = (bf16*)(p.ws + WS_YM);
    __shared__ float sc[4][NMETA + SEQ];
    __shared__ float sq[4][64];
    int nk, b = 0;
    if (r >= MX) nk = NMETA; else { b = r >> 11; int t = r & 2047; nk = NMETA + 64 * (t / 64 + 1); }
    const float l1 = wave_sum(p.in[I_LQ1][lane] * p.in[I_LK1][lane]);
    const float l2 = wave_sum(p.in[I_LQ2][lane] * p.in[I_LK2][lane]);
    const float lam = expf(l1) - expf(l2) + LAM_INIT;
    float o[2][2];
    for (int c = 0; c < 2; ++c) {
        sq[h][lane] = bf2f(Z[(size_t)r * NZ0 + 512 + h * 128 + c * 64 + lane]);
        __syncthreads();
        float mx = -1e30f;
        for (int kk = lane; kk < nk; kk += 64) {
            const size_t kr = kk < NMETA ? (size_t)(MX + kk) : (size_t)b * SEQ + (kk - NMETA);
            const bf16* kp = Z + kr * NZ0 + 1024 + h * 128 + c * 64;
            float s = 0.f;
            for (int d = 0; d < 64; ++d) s += sq[h][d] * bf2f(kp[d]);
            sc[h][kk] = s; mx = fmaxf(mx, s);
        }
        mx = wave_max(mx);
        float l = 0.f;
        for (int kk = lane; kk < nk; kk += 64) { float e = exp2f(sc[h][kk] - mx); sc[h][kk] = e; l += e; }
        l = wave_sum(l);
        __syncthreads();
        float a0 = 0.f, a1 = 0.f;
        for (int kk = 0; kk < nk; ++kk) {
            const size_t kr = kk < NMETA ? (size_t)(MX + kk) : (size_t)b * SEQ + (kk - NMETA);
            const bf16* vp = Z + kr * NZ0 + 1536 + h * 128 + lane * 2;
            const float pw = sc[h][kk];
            a0 += pw * bf2f(vp[0]); a1 += pw * bf2f(vp[1]);
        }
        o[c][0] = a0 / l; o[c][1] = a1 / l;
        __syncthreads();
    }
    float v0 = o[0][0] - lam * o[1][0], v1 = o[0][1] - lam * o[1][1];
    float ss = wave_sum(v0 * v0 + v1 * v1);
    float rs = 1.f / sqrtf(ss / 128.f + LN_EPS);
    v0 = v0 * rs * p.in[I_SUBLN][lane * 2] * (1.f - LAM_INIT); v1 = v1 * rs * p.in[I_SUBLN][lane * 2 + 1] * (1.f - LAM_INIT);
    YM[(size_t)r * D + 512 + h * 128 + lane * 2] = f2bf(v0);
    YM[(size_t)r * D + 512 + h * 128 + lane * 2 + 1] = f2bf(v1);
}

template <int L> __global__ void __launch_bounds__(256) n_router(P p) {
    const int wave = threadIdx.x >> 6, lane = threadIdx.x & 63;
    const int r = blockIdx.x * 4 + wave; if (r >= MR) return;
    const bf16* R1 = (const bf16*)(p.ws + WS_R1); bf16* Hb = (bf16*)(p.ws + WS_HB);
    const float* g = p.in[L ? I_L1LN1G : I_L0LN1G]; const float* bb = p.in[L ? I_L1LN1B : I_L0LN1B];
    const float* wc = p.in[L ? I_M1WC : I_M0WC]; const float* bc = p.in[L ? I_M1BC : I_M0BC];
    const float* wf = p.in[L ? I_M1WF : I_M0WF]; const float* bfi = p.in[L ? I_M1BF : I_M0BF];
    float v[16]; float s = 0.f;
#pragma unroll
    for (int j = 0; j < 16; ++j) { v[j] = bf2f(R1[(size_t)r * D + j * 64 + lane]); s += v[j]; }
    const float mean = wave_sum(s) / D; float q = 0.f;
#pragma unroll
    for (int j = 0; j < 16; ++j) { v[j] -= mean; q += v[j] * v[j]; }
    const float rstd = 1.f / sqrtf(wave_sum(q) / D + LN_EPS);
#pragma unroll
    for (int j = 0; j < 16; ++j) { int c = j * 64 + lane; bf16 hb = f2bf(v[j] * rstd * g[c] + bb[c]); v[j] = bf2f(hb); Hb[(size_t)r * D + c] = hb; }
    float lc[4];
#pragma unroll
    for (int c4 = 0; c4 < 4; ++c4) { float a = 0.f;
#pragma unroll
        for (int j = 0; j < 16; ++j) a += v[j] * wc[(size_t)(j * 64 + lane) * 4 + c4];
        lc[c4] = wave_sum(a) + bc[c4]; }
    int grp = 0; float mxc = lc[0];
#pragma unroll
    for (int c4 = 1; c4 < 4; ++c4) if (lc[c4] > mxc) { mxc = lc[c4]; grp = c4; }
    float se = 0.f;
#pragma unroll
    for (int c4 = 0; c4 < 4; ++c4) se += expf(lc[c4] - mxc);
    const float pgrp = 1.f / se;
    float lf[8];
#pragma unroll
    for (int e8 = 0; e8 < 8; ++e8) { float a = 0.f;
#pragma unroll
        for (int j = 0; j < 16; ++j) a += v[j] * wf[((size_t)grp * D + j * 64 + lane) * 8 + e8];
        lf[e8] = wave_sum(a) + bfi[grp * 8 + e8]; }
    int i0 = 0; float v0 = lf[0];
#pragma unroll
    for (int e8 = 1; e8 < 8; ++e8) if (lf[e8] > v0) { v0 = lf[e8]; i0 = e8; }
    int i1 = -1; float v1 = -1e30f;
#pragma unroll
    for (int e8 = 0; e8 < 8; ++e8) if (e8 != i0 && lf[e8] > v1) { v1 = lf[e8]; i1 = e8; }
    const float e1 = expf(v1 - v0); const float g0 = pgrp / (1.f + e1), g1 = pgrp * e1 / (1.f + e1);
    if (lane == 0) {
        int* cnt = (int*)(p.ws + WS_CTL) + (L ? CW_CNT1 : CW_CNT0);
        int* list = (int*)(p.ws + WS_ROUTE); float* gate = (float*)(p.ws + WS_GATE);
        const int ea = grp * 8 + i0, eb = grp * 8 + i1;
        int pa = atomicAdd(&cnt[CNT_IDX(ea)], 1); list[(size_t)ea * LIST_CAP + pa] = r * 2; gate[r * 2] = g0;
        int pb = atomicAdd(&cnt[CNT_IDX(eb)], 1); list[(size_t)eb * LIST_CAP + pb] = r * 2 + 1; gate[r * 2 + 1] = g1;
    }
}
template <int L> __global__ void n_ebase(P p) {
    if (threadIdx.x == 0) { const int* cnt = (const int*)(p.ws + WS_CTL) + (L ? CW_CNT1 : CW_CNT0); int* ebase = (int*)(p.ws + WS_EBASE);
        int acc = 0; for (int e = 0; e < NE; ++e) { ebase[e] = acc; acc += (cnt[CNT_IDX(e)] + 255) / 256 * 256; } }
}
template <int L> __global__ void __launch_bounds__(256) n_combine(P p) {
    const int wave = threadIdx.x >> 6, lane = threadIdx.x & 63;
    const int r = blockIdx.x * 4 + wave; if (r >= MR) return;
    bf16* Hb = (bf16*)(p.ws + WS_HB); const bf16* Y2 = (const bf16*)(p.ws + WS_Z);
    const float* g = p.in[L ? I_L1LN2G : I_L0LN2G]; const float* bb = p.in[L ? I_L1LN2B : I_L0LN2B];
    float v[16]; float s = 0.f;
#pragma unroll
    for (int j = 0; j < 16; ++j) { int c = j * 64 + lane; v[j] = ALPHA * bf2f(Hb[(size_t)r * D + c]) + bf2f(Y2[(size_t)(2 * r) * D + c]) + bf2f(Y2[(size_t)(2 * r + 1) * D + c]); s += v[j]; }
    const float mean = wave_sum(s) / D; float q = 0.f;
#pragma unroll
    for (int j = 0; j < 16; ++j) { v[j] -= mean; q += v[j] * v[j]; }
    const float rstd = 1.f / sqrtf(wave_sum(q) / D + LN_EPS);
#pragma unroll
    for (int j = 0; j < 16; ++j) { int c = j * 64 + lane; float o = v[j] * rstd * g[c] + bb[c];
        if (L == 0) Hb[(size_t)r * D + c] = f2bf(o); else if (r < MX) p.out[(size_t)r * D + c] = o; }
}
__global__ void __launch_bounds__(128) n_lru(P p) {
    const int b = blockIdx.x / 10, n = blockIdx.x % 10, c = threadIdx.x, ch = n * 128 + c;
    const bf16* Z = (const bf16*)(p.ws + WS_Z); bf16* Y1 = (bf16*)(p.ws + WS_YM);
    __shared__ float xc[128];
    const float cw0 = p.in[I_CONVW][ch], cw1 = p.in[I_CONVW][DRNN + ch], cw2 = p.in[I_CONVW][2 * DRNN + ch], cw3 = p.in[I_CONVW][3 * DRNN + ch], cb = p.in[I_CONVB][ch];
    const float* wa = p.in[I_WA] + (size_t)n * 128 * 128; const float* wx = p.in[I_WX] + (size_t)n * 128 * 128;
    const float ba = p.in[I_BA][ch], bx = p.in[I_BX][ch];
    const float lam = p.in[I_LAM][ch]; const float sp = log1pf(expf(-lam));
    float r0 = 0.f, r1 = 0.f, r2 = 0.f, hstate = 0.f;
    for (int s = 0; s < NMETA + SEQ; ++s) {
        const size_t row = s < NMETA ? (size_t)(MX + s) : (size_t)b * SEQ + (s - NMETA);
        const float r3 = bf2f(Z[row * NZ1 + DRNN + ch]);
        const float x = r0 * cw0 + r1 * cw1 + r2 * cw2 + r3 * cw3 + cb;
        r0 = r1; r1 = r2; r2 = r3;
        xc[c] = x;
        __syncthreads();
        float aa = 0.f, ax = 0.f;
        for (int d = 0; d < 128; ++d) { const float xv = xc[d]; aa += xv * wa[d * 128 + c]; ax += xv * wx[d * 128 + c]; }
        const float rg = sigmoidf_(aa + ba), ig = sigmoidf_(ax + bx);
        const float log_a = -8.f * rg * sp; const float a = expf(log_a);
        const float bt = sqrtf(-expm1f(2.f * log_a)) * (ig * x);
        hstate = a * hstate + bt;
        if (s >= NMETA || b == 0) Y1[row * DRNN + ch] = f2bf(bf2f(Z[row * NZ1 + ch]) * hstate);
        __syncthreads();
    }
}

namespace pg8 {
#define PG8_LAS __attribute__((address_space(3)))
typedef unsigned short bf16_t;
typedef short bf16x8 __attribute__((ext_vector_type(8)));
typedef float f32x4 __attribute__((ext_vector_type(4)));
typedef float f32x2 __attribute__((ext_vector_type(2)));
typedef unsigned u32x4 __attribute__((ext_vector_type(4)));
typedef unsigned u32x2 __attribute__((ext_vector_type(2)));
constexpr int BM = 256, BK = 64, HALF = 128, HTB = HALF * BK * 2  , STAGE_BYTES = 8 * HTB, NXCD = 8, WGM = 8;

__host__ __device__ __forceinline__ int lds_byte(int r, int c) { const int st = (r >> 4) * 2 + (c >> 5), rr = r & 15, cc = c & 31, ob = rr * 64 + cc * 2; return st * 1024 + (ob ^ (((ob >> 9) & 1) << 5)); }
__host__ __device__ __forceinline__ void stage_rc(int b, int& R, int& C) { const int st = b / 1024, sb = b % 1024, swz = sb ^ (((sb >> 9) & 1) << 5); R = (st >> 1) * 16 + swz / 64; C = (st & 1) * 32 + (swz % 64) / 2; }
__host__ __device__ __forceinline__ int perm32(int rho) { const int n = rho >> 4, i = rho & 15; return 8 * (i >> 2) + 4 * n + (i & 3); }

struct Unit { const char* a; const char* b; int pm, pn, ex, nrow; };

struct DenseOrder {
    static constexpr bool GATHER = false;
    const char* A; const char* Bt; int K; int nM, nN, nwg, G, c;
    __device__ void init(const void* A_, const void* Bt_, int M, int N, int K_, int G_, int c_) { A = (const char*)A_; Bt = (const char*)Bt_; K = K_; nM = M / BM; nN = N / BM; nwg = nM * nN; G = G_; c = c_; }
    __device__ bool next(int i, Unit& u) const {
        const long L = (long)i * G + c; if (L >= nwg) return false;
        int wgid = (int)L; { const int q = nwg / NXCD, r = nwg % NXCD, xcd = wgid % NXCD, off = wgid / NXCD; wgid = (xcd < r ? xcd * (q + 1) : r * (q + 1) + (xcd - r) * q) + off; }
        const int nig = WGM * nN, gid = wgid / nig, fm = gid * WGM, gsz = (nM - fm) < WGM ? (nM - fm) : WGM;
        u.pm = fm + ((wgid % nig) % gsz); u.pn = (wgid % nig) / gsz; u.ex = 0; u.nrow = BM;
        u.a = A + (size_t)u.pm * BM * K * 2; u.b = Bt + (size_t)u.pn * BM * K * 2; return true;
    }
    __device__ __forceinline__ void voffs(const Unit&, int, unsigned (&)[2], unsigned (&)[2]) const {}
};

__device__ __forceinline__ unsigned cvt_pk_bf16(float lo, float hi) { unsigned r; asm volatile("v_cvt_pk_bf16_f32 %0, %1, %2" : "=v"(r) : "v"(lo), "v"(hi)); return r; }

template <class Epi, class Sched, bool ALIGN_EPI>
__device__ __forceinline__ void gemm_phase(PG8_LAS unsigned char* lds, const int K, const Sched& S, const Epi& E) {
    constexpr bool GATHER = Sched::GATHER;
    int tid_ = threadIdx.x; asm volatile("" : "+v"(tid_));
    const int tid = tid_, wid = __builtin_amdgcn_readfirstlane(tid >> 6), lane = tid & 63, wr = wid >> 2, wc = wid & 3, fr = lane & 15, fq = lane >> 4;
    const int nt = K / BK;
    unsigned voffA[2], voffA1[2], voffB[2];
#pragma unroll
    for (int i = 0; i < 2; ++i) { int R, C; stage_rc(tid * 16 + i * 8192, R, C); const int Rb = Epi::PERM ? ((R & ~31) + perm32(R & 31)) : R;
        voffA[i] = (unsigned)(R * K + C) * 2u; voffA1[i] = voffA[i]; voffB[i] = (unsigned)(Rb * K + C) * 2u; }
    const size_t kstep = (size_t)(BK * 2);
    const size_t hstep = (size_t)HALF * K * 2;
    const size_t hstepA = GATHER ? 0 : hstep;
    const unsigned ldsw = (unsigned)wid * 1024u;
    const int aoff = lds_byte(wr * 64 + fr, fq * 8), boff = lds_byte(wc * 32 + fr, fq * 8);
#define PG8_SA(b, h) (((b) * 2 + (h)) * HTB)
#define PG8_SB(b, h) ((4 + (b) * 2 + (h)) * HTB)
#define PG8_STAGE(bufoff, gbase, voff) do { _Pragma("unroll") for (int _i = 0; _i < 2; ++_i) \
        __builtin_amdgcn_global_load_lds((const unsigned*)((const char*)(gbase) + (voff)[_i]), (PG8_LAS unsigned*)(lds + (bufoff) + ldsw + _i * 8192), 16, 0, 0); } while (0)
#define PG8_STAGE_A0(b, gbase) PG8_STAGE(PG8_SA(b, 0), gbase, voffA)
#define PG8_STAGE_A1(b, gbase) PG8_STAGE(PG8_SA(b, 1), (gbase) + hstepA, voffA1)
#define PG8_LDA(dst, b, h) do { _Pragma("unroll") for (int m = 0; m < 4; ++m) _Pragma("unroll") for (int k = 0; k < 2; ++k) dst[m][k] = *(const PG8_LAS bf16x8*)(lds + PG8_SA(b, h) + aoff + m * 2048 + k * 1024); } while (0)
#define PG8_LDB(dst, b, h) do { _Pragma("unroll") for (int n = 0; n < 2; ++n) _Pragma("unroll") for (int k = 0; k < 2; ++k) dst[n][k] = *(const PG8_LAS bf16x8*)(lds + PG8_SB(b, h) + boff + n * 2048 + k * 1024); } while (0)
#define PG8_MMA(ai, bj, At, Bt) do { __builtin_amdgcn_s_setprio(1); _Pragma("unroll") for (int m = 0; m < 4; ++m) _Pragma("unroll") for (int n = 0; n < 2; ++n) _Pragma("unroll") for (int k = 0; k < 2; ++k) \
        acc[ai][bj][m][n] = __builtin_amdgcn_mfma_f32_16x16x32_bf16(Bt[n][k], At[m][k], acc[ai][bj][m][n], 0, 0, 0); __builtin_amdgcn_s_setprio(0); } while (0)
#define PG8_WAIT_V(n) asm volatile("s_waitcnt vmcnt(" #n ")" ::: "memory")
#define PG8_WAIT_L(n) asm volatile("s_waitcnt lgkmcnt(" #n ")" ::: "memory")
#define PG8_BAR __builtin_amdgcn_s_barrier()
#define PG8_SCHED __builtin_amdgcn_sched_barrier(0)
    Unit cur, nxt; int ui = 0;
    if (!S.next(0, cur)) return;
    if (GATHER) S.voffs(cur, tid, voffA, voffA1);
    f32x4 acc[2][2][4][2];
#pragma unroll
    for (int a = 0; a < 2; ++a)
#pragma unroll
        for (int b = 0; b < 2; ++b)
#pragma unroll
            for (int m = 0; m < 4; ++m)
#pragma unroll
                for (int n = 0; n < 2; ++n) acc[a][b][m][n] = (f32x4){0.f, 0.f, 0.f, 0.f};
    bf16x8 At[4][2], B0[2][2], B1[2][2];
    const char* cA = cur.a; const char* cB = cur.b;
    PG8_STAGE(PG8_SB(0, 0), cB, voffB); PG8_STAGE(PG8_SB(0, 1), cB + hstep, voffB); PG8_STAGE_A0(0, cA); PG8_STAGE_A1(0, cA);
    if (wr == 1) PG8_BAR;
    PG8_WAIT_V(2); PG8_BAR;
    PG8_STAGE(PG8_SB(1, 0), cB + kstep, voffB); PG8_STAGE_A0(1, cA + kstep); PG8_STAGE(PG8_SB(1, 1), cB + hstep + kstep, voffB);
    PG8_WAIT_V(6); PG8_BAR;
    for (;;) {
        const bool has_next = S.next(ui + 1, nxt);
        const char* nA = has_next ? nxt.a : cA; const char* nB = has_next ? nxt.b : cB;
        for (int t = 0; t < nt; t += 2) {
            const bool last = (t == nt - 2);
            const char* a1 = cA + (size_t)(t + 1) * kstep;
            const char* a2 = last ? nA : cA + (size_t)(t + 2) * kstep; const char* b2 = last ? nB : cB + (size_t)(t + 2) * kstep;
            const char* a3 = a2 + kstep; const char* b3 = b2 + kstep;
            PG8_LDB(B0, 0, 0); PG8_LDB(B1, 0, 1); PG8_SCHED; PG8_LDA(At, 0, 0); PG8_STAGE_A1(1, a1);
            if (GATHER) { if (last && has_next) S.voffs(nxt, tid, voffA, voffA1); }
            PG8_WAIT_V(8); PG8_WAIT_L(0); PG8_BAR; PG8_MMA(0, 0, At, B0); PG8_MMA(0, 1, At, B1); PG8_BAR; PG8_SCHED;
            PG8_LDA(At, 0, 1); PG8_STAGE(PG8_SB(0, 0), b2, voffB); PG8_STAGE(PG8_SB(0, 1), b2 + hstep, voffB); PG8_STAGE_A0(0, a2);
            PG8_WAIT_V(8); PG8_WAIT_L(0); PG8_BAR; PG8_MMA(1, 0, At, B0); PG8_MMA(1, 1, At, B1); PG8_BAR; PG8_SCHED;
            PG8_LDB(B0, 1, 0); PG8_LDB(B1, 1, 1); PG8_SCHED; PG8_LDA(At, 1, 0); PG8_STAGE_A1(0, a2);
            PG8_WAIT_V(8); PG8_WAIT_L(0); PG8_BAR; PG8_MMA(0, 0, At, B0); PG8_MMA(0, 1, At, B1); PG8_BAR; PG8_SCHED;
            PG8_LDA(At, 1, 1); PG8_STAGE(PG8_SB(1, 0), b3, voffB); PG8_STAGE(PG8_SB(1, 1), b3 + hstep, voffB); PG8_STAGE_A0(1, a3);
            PG8_WAIT_V(8); PG8_WAIT_L(0); PG8_BAR; PG8_MMA(1, 0, At, B0); PG8_MMA(1, 1, At, B1); PG8_BAR; PG8_SCHED;
        }
        if constexpr (ALIGN_EPI) { if (wr == 0) PG8_BAR; }
        E(acc, cur, wr, wc, fr, fq);
        if (!has_next) break;
#pragma unroll
        for (int a = 0; a < 2; ++a)
#pragma unroll
            for (int b = 0; b < 2; ++b)
#pragma unroll
                for (int m = 0; m < 4; ++m)
#pragma unroll
                    for (int n = 0; n < 2; ++n) acc[a][b][m][n] = (f32x4){0.f, 0.f, 0.f, 0.f};
        cur = nxt; cA = nA; cB = nB; ++ui;
        if constexpr (ALIGN_EPI) { if (wr == 1) PG8_BAR; }
    }
    PG8_WAIT_V(0);
    if constexpr (!ALIGN_EPI) { if (wr == 0) PG8_BAR; }
    PG8_BAR;
#undef PG8_SA
#undef PG8_SB
#undef PG8_STAGE
#undef PG8_STAGE_A0
#undef PG8_STAGE_A1
#undef PG8_LDA
#undef PG8_LDB
#undef PG8_MMA
#undef PG8_WAIT_V
#undef PG8_WAIT_L
#undef PG8_BAR
#undef PG8_SCHED
}
}
#define GAS __attribute__((address_space(1)))
#define LAS __attribute__((address_space(3)))
typedef unsigned v4u __attribute__((ext_vector_type(4)));
typedef float f32x4 __attribute__((ext_vector_type(4)));
typedef short bf16x8 __attribute__((ext_vector_type(8)));
#define LDS_WAIT() asm volatile("s_waitcnt lgkmcnt(0)" ::: "memory")
#define VM_WAIT() asm volatile("s_waitcnt vmcnt(0)" ::: "memory")
__device__ __forceinline__ unsigned pk2(float lo, float hi) { return (unsigned)f2bf(lo) | ((unsigned)f2bf(hi) << 16); }

#define XB_TMO      128
#define XB_XCNT(j)  (256  + 64 * (j))
#define XB_XSUB(j)  (1280 + 64 * (j))
#define XB_XGEN(j)  (2304 + 64 * (j))
#define XB_TOP      3328
#define XB_TOPGEN   3392
#define XCD_BAR_WORDS 3456
#define XB_SPIN_CAP (1u << 18)
__device__ __forceinline__ unsigned xb_ld(unsigned* p)              { return __hip_atomic_load(p, __ATOMIC_RELAXED, __HIP_MEMORY_SCOPE_AGENT); }
__device__ __forceinline__ unsigned xb_add(unsigned* p, unsigned v) { return __hip_atomic_fetch_add(p, v, __ATOMIC_RELAXED, __HIP_MEMORY_SCOPE_AGENT); }
__device__ __forceinline__ unsigned xb_xcc_id() { return (unsigned)__builtin_amdgcn_s_getreg((3 << 11) | 20) & 0xFu; }
#define XB_SPIN(cond, bar) do { unsigned _sp = 0; while (cond) { __builtin_amdgcn_s_sleep(1); \
    if ((++_sp & 255u) == 0u) { if (xb_ld(&(bar)[XB_TMO])) break; if (_sp > XB_SPIN_CAP) { atomicAdd(&(bar)[XB_TMO], 1u); break; } } } } while (0)
struct XcdBarrier { unsigned* bar; unsigned x; volatile LAS unsigned* st; };
__device__ __forceinline__ XcdBarrier xcd_barrier_post(unsigned* bar, volatile LAS unsigned* st) {
    XcdBarrier b; b.bar = bar; b.x = xb_xcc_id(); b.st = st;
    if (threadIdx.x == 0) (void)xb_add(&bar[XB_XCNT(b.x)], 1u);
    return b;
}
__device__ __forceinline__ void xcd_barrier_complete(unsigned* bar, unsigned x, unsigned& nloc, unsigned& nx) {
    const unsigned G = gridDim.x * gridDim.y * gridDim.z;
    unsigned sum, cnt, mine, sp = 0u;
    for (;;) {
        sum = 0u; cnt = 0u; mine = 0u;
#pragma unroll
        for (unsigned j = 0; j < 16; ++j) { const unsigned c = xb_ld(&bar[XB_XCNT(j)]); sum += c; cnt += (c > 0u) ? 1u : 0u; mine = (j == x) ? c : mine; }
        if (sum == G) break;
        __builtin_amdgcn_s_sleep(1);
        if ((++sp & 255u) == 0u) { if (xb_ld(&bar[XB_TMO])) break; if (sp > XB_SPIN_CAP) { atomicAdd(&bar[XB_TMO], 1u); break; } }
    }
    nloc = mine > 0u ? mine : 1u; nx = cnt > 0u ? cnt : 1u;
}
__device__ __forceinline__ void xcd_barrier(const XcdBarrier& b) {
    asm volatile("s_waitcnt vmcnt(0)" ::: "memory");
    __syncthreads();
    if (threadIdx.x == 0) {
        unsigned* bar = b.bar;
        __builtin_amdgcn_s_waitcnt(0);
        unsigned nloc = b.st[0], nx = b.st[1];
        if (nloc == 0u) { xcd_barrier_complete(bar, b.x, nloc, nx); b.st[0] = nloc; b.st[1] = nx; }
        const unsigned old = xb_add(&bar[XB_XSUB(b.x)], 1u);
        const unsigned gen = old / nloc;
        if (old + 1u == (gen + 1u) * nloc) {
            __builtin_amdgcn_fence(__ATOMIC_RELEASE, "agent");
            asm volatile("s_waitcnt vmcnt(0)" ::: "memory");
            const unsigned og = xb_add(&bar[XB_TOP], 1u);
            const unsigned tg = og / nx;
            if (og + 1u == (tg + 1u) * nx) xb_add(&bar[XB_TOPGEN], 1u);
            else XB_SPIN(xb_ld(&bar[XB_TOPGEN]) == tg, bar);
            __builtin_amdgcn_fence(__ATOMIC_ACQUIRE, "agent");
            xb_add(&bar[XB_XGEN(b.x)], 1u);
            asm volatile("s_waitcnt vmcnt(0)" ::: "memory");
        } else {
            XB_SPIN(xb_ld(&bar[XB_XGEN(b.x)]) == gen, bar);
            __builtin_amdgcn_fence(__ATOMIC_ACQUIRE, "agent");
            asm volatile("s_waitcnt vmcnt(0)" ::: "memory");
        }
    }
    __syncthreads();
}

constexpr int RING_BYTES = 131072;
constexpr int MISC_OFF = RING_BYTES + 320;
constexpr int LDS_BYTES = 147456;
constexpr int NWAVES = 8;
constexpr int CW_BAR = 4096;

constexpr size_t WB_WIN0 = WS_WB;
constexpr size_t WB_WGLU = WB_WIN0 + 4 * MiB;
constexpr size_t WB_WOUT0 = WB_WGLU + MiB / 2;
constexpr size_t WB_WIN1 = WB_WOUT0 + 2 * MiB;
constexpr size_t WB_WOUT1 = WB_WIN1 + 5 * MiB;
constexpr size_t WB_WAX = WB_WOUT1 + 5 * MiB / 2;
constexpr size_t WB_END = WB_WAX + MiB;
constexpr size_t MOE_WGU = 0, MOE_WD = 64 * MiB;

struct Frame {
    LAS unsigned char* lds;
    int tid, lane, wave, G, vcu;
};

struct CvtDesc { const float* src; bf16* dst; int N, ldt; };
__device__ __forceinline__ void ti_load(const CvtDesc& d, f32x4 (&v)[16], int lane, int abl = 0) {
    if (abl & 2) { _Pragma("unroll") for (int i = 0; i < 16; ++i) v[i] = (f32x4){1.f, 2.f, 3.f, 4.f}; return; }
#pragma unroll
    for (int i = 0; i < 16; ++i) v[i] = *(const f32x4*)(d.src + (size_t)(4 * i + (lane >> 4)) * d.N + 4 * (lane & 15));
}
__device__ __forceinline__ int ti_idx(int kk, int n) { return kk * 64 + (n ^ (4 * ((kk >> 3) ^ (kk & 7)))); }
__device__ __forceinline__ void ti_finish(const CvtDesc& d, const f32x4 (&v)[16], LAS float* scr, int lane, int abl = 0) {
#pragma unroll
    for (int i = 0; i < 16; ++i) *(LAS f32x4*)(scr + ti_idx(4 * i + (lane >> 4), 4 * (lane & 15))) = v[i];
    LDS_WAIT(); asm volatile("" ::: "memory");
    const int c = lane & 7;
#pragma unroll
    for (int j = 0; j < 8; ++j) { const int n = (lane >> 3) + 8 * j;
        float s[8];
#pragma unroll
        for (int e = 0; e < 8; ++e) s[e] = scr[ti_idx(8 * c + e, n)];
        v4u o; o.x = pk2(s[0], s[1]); o.y = pk2(s[2], s[3]); o.z = pk2(s[4], s[5]); o.w = pk2(s[6], s[7]);
        if (!(abl & 1)) *(GAS v4u*)(d.dst + (size_t)n * d.ldt + 8 * c) = o; else asm volatile("" :: "v"(o)); }
    LDS_WAIT(); asm volatile("" ::: "memory");
}
constexpr int CI_WIN0 = 512, CI_WGLU = 64, CI_WOUT0 = 256, CI_WIN1 = 640, CI_WOUT1 = 320, CI_WAX = 80, CI_MOE = 12288;
constexpr int CI_SMALL = CI_WIN0 + CI_WGLU + CI_WOUT0 + CI_WIN1 + CI_WOUT1 + CI_WAX;
constexpr int CI_TOTAL = CI_SMALL + 2 * CI_MOE;
struct ArgsF { P p; int ph_lo, ph_hi, li, pad; };
typedef __attribute__((address_space(4))) const ArgsF CArgsF;
__device__ __forceinline__ CvtDesc cvt_desc(CArgsF* q, int it) {
    const float* W; int N, K, r = it; bf16* WT;
    if (r < CI_WIN0) { W = q->p.in[I_L0WIN]; K = D; N = NZ0; WT = (bf16*)(q->p.ws + WB_WIN0); }
    else if ((r -= CI_WIN0) < CI_WGLU) { W = q->p.in[I_WGLU]; K = 512; N = 512; WT = (bf16*)(q->p.ws + WB_WGLU); }
    else if ((r -= CI_WGLU) < CI_WOUT0) { W = q->p.in[I_L0WOUT]; K = D; N = D; WT = (bf16*)(q->p.ws + WB_WOUT0); }
    else if ((r -= CI_WOUT0) < CI_WIN1) { W = q->p.in[I_L1WIN]; K = D; N = NZ1; WT = (bf16*)(q->p.ws + WB_WIN1); }
    else if ((r -= CI_WIN1) < CI_WOUT1) { W = q->p.in[I_L1WOUT]; K = DRNN; N = D; WT = (bf16*)(q->p.ws + WB_WOUT1); }
    else if ((r -= CI_WOUT1) < CI_WAX) { const int blk = r >> 3, gsel = (r >> 2) & 1; r &= 3;
        W = (gsel ? q->p.in[I_WX] : q->p.in[I_WA]) + (size_t)blk * 128 * 128; K = 128; N = 128; WT = (bf16*)(q->p.ws + WB_WAX) + (size_t)(blk * 2 + gsel) * 128 * 128; }
    else { r -= CI_WAX; const int L = r >= CI_MOE; if (L) r -= CI_MOE; const int e = r / 384; r -= e * 384; const int which = r >> 7; r &= 127;
        unsigned char* mb = q->p.ws + (L ? WS_MOE1 : WS_MOE0);
        if (which < 2) {
            W = (L ? (which ? q->p.in[I_M1WU] : q->p.in[I_M1WG]) : (which ? q->p.in[I_M0WU] : q->p.in[I_M0WG])) + (size_t)e * D * 512;
            const int kb = r / 8, nb = r % 8, n0 = nb * 64, k0 = kb * 64;
            bf16* dst = (bf16*)(mb + MOE_WGU) + ((size_t)e * 1024 + 256 * (n0 >> 7) + (n0 & 127) + 128 * which) * 1024 + k0;
            return CvtDesc{W + (size_t)k0 * 512 + n0, dst, 512, 1024}; }
        W = (L ? q->p.in[I_M1WD] : q->p.in[I_M0WD]) + (size_t)e * 512 * D; K = 512; N = D; WT = (bf16*)(mb + MOE_WD) + (size_t)e * 1024 * 512; }
    const int nblk = N / 64, kb = r / nblk, nb = r % nblk, k0 = kb * 64, n0 = nb * 64;
    return CvtDesc{W + (size_t)k0 * N + n0, WT + (size_t)n0 * K + k0, N, K};
}
__device__ __forceinline__ void cvt_range(CArgsF* q, int first, int end, int stride, LAS float* scr, int lane, int abl = 0) {
    asm volatile("" : "+s"(q));
#pragma unroll 1
    for (int it = first; it < end; it += stride) { f32x4 v[16]; const CvtDesc d = cvt_desc(q, it); ti_load(d, v, lane, abl); ti_finish(d, v, scr, lane, abl); }
}
template <class E>
__device__ __forceinline__ void meta_gemm(const Frame& F, const P& p, const bf16* A16, int lda, const bf16* Bt, int N, int K, const E& e) {
    const int lane = F.lane, r = lane & 15, q = lane >> 4, kc = K >> 3;
    LAS float* red = (LAS float*)F.lds;
    for (int tile = F.vcu; tile < N / 16; tile += F.G) {
        f32x4 acc = {0.f, 0.f, 0.f, 0.f};
        const bf16* ap = A16 + (size_t)r * lda + q * 8 + F.wave * kc; const bf16* bp = Bt + (size_t)(tile * 16 + r) * K + q * 8 + F.wave * kc;
#pragma unroll 5
        for (int k = 0; k < kc; k += 32) {
            const bf16x8 a = *(const bf16x8*)(ap + k); const bf16x8 b = *(const bf16x8*)(bp + k);
            acc = __builtin_amdgcn_mfma_f32_16x16x32_bf16(a, b, acc, 0, 0, 0);
        }
        *(LAS f32x4*)(red + (F.wave * 64 + lane) * 4) = acc;
        __syncthreads();
        if (F.wave == 0) {
#pragma unroll
            for (int w = 1; w < 8; ++w) acc += *(const LAS f32x4*)(red + (w * 64 + lane) * 4);
#pragma unroll
            for (int i = 0; i < 4; ++i) e.store(p, 0, MX + q * 4 + i, tile * 16 + r, acc[i], 0.f);
        }
        __syncthreads();
    }
}

struct FEpiZ0 {
    static constexpr bool PERM = true;
    bf16* Z;
    __device__ __forceinline__ void operator()(const pg8::f32x4 (&acc)[2][2][4][2], const pg8::Unit& u, int wr, int wc, int fr, int fq) const {
        const int row0 = u.pm * 256 + wr * 64 + fr, col0 = u.pn * 256 + wc * 32 + 8 * fq;
        const float sc = (u.pn == 2 || u.pn == 3) ? QSCALE : 1.f;
#pragma unroll
        for (int ai = 0; ai < 2; ++ai)
#pragma unroll
            for (int m = 0; m < 4; ++m) { bf16* rowp = Z + (size_t)(row0 + ai * 128 + m * 16) * NZ0 + col0;
#pragma unroll
                for (int bj = 0; bj < 2; ++bj) { const pg8::f32x4 v0 = acc[ai][bj][m][0] * sc, v1 = acc[ai][bj][m][1] * sc;
                    pg8::u32x4 w; w.x = pg8::cvt_pk_bf16(v0[0], v0[1]); w.y = pg8::cvt_pk_bf16(v0[2], v0[3]); w.z = pg8::cvt_pk_bf16(v1[0], v1[1]); w.w = pg8::cvt_pk_bf16(v1[2], v1[3]);
                    *(pg8::u32x4*)(rowp + bj * 128) = w; } }
    }
};


__device__ __forceinline__ float fast_sigmoid(float v) { return __builtin_amdgcn_rcpf(1.f + __builtin_amdgcn_exp2f(-1.4426950408889634f * v)); }
__device__ __forceinline__ float fast_gelu(float x) { const float u = x + 0.044715f * x * x * x; return x * __builtin_amdgcn_rcpf(1.f + __builtin_amdgcn_exp2f(-2.302208198f * u)); }
__device__ __forceinline__ pg8::u32x4 pack8(const pg8::f32x4& v0, const pg8::f32x4& v1) {
    pg8::u32x4 w; w.x = pg8::cvt_pk_bf16(v0[0], v0[1]); w.y = pg8::cvt_pk_bf16(v0[2], v0[3]); w.z = pg8::cvt_pk_bf16(v1[0], v1[1]); w.w = pg8::cvt_pk_bf16(v1[2], v1[3]); return w; }
__device__ __forceinline__ void unpack8(const pg8::u32x4& w, pg8::f32x4& v0, pg8::f32x4& v1) {
    v0[0] = __uint_as_float(w.x << 16); v0[1] = __uint_as_float(w.x & 0xffff0000u); v0[2] = __uint_as_float(w.y << 16); v0[3] = __uint_as_float(w.y & 0xffff0000u);
    v1[0] = __uint_as_float(w.z << 16); v1[1] = __uint_as_float(w.z & 0xffff0000u); v1[2] = __uint_as_float(w.w << 16); v1[3] = __uint_as_float(w.w & 0xffff0000u); }

struct FEpiGLU {
    static constexpr bool PERM = true;
    const bf16* YP; bf16* YM; const float* bias;
    __device__ __forceinline__ void operator()(const pg8::f32x4 (&acc)[2][2][4][2], const pg8::Unit& u, int wr, int wc, int fr, int fq) const {
        const int row0 = u.pm * 256 + wr * 64 + fr, col0 = u.pn * 256 + wc * 32 + 8 * fq;
#pragma unroll
        for (int bj = 0; bj < 2; ++bj) { const pg8::f32x4 b0 = *(const pg8::f32x4*)(bias + col0 + bj * 128), b1 = *(const pg8::f32x4*)(bias + col0 + bj * 128 + 4);
#pragma unroll
            for (int ai = 0; ai < 2; ++ai)
#pragma unroll
                for (int m = 0; m < 4; ++m) { const size_t row = (size_t)(row0 + ai * 128 + m * 16);
                    pg8::f32x4 y0, y1; unpack8(*(const pg8::u32x4*)(YP + row * 512 + col0 + bj * 128), y0, y1);
                    pg8::f32x4 v0 = acc[ai][bj][m][0] + b0, v1 = acc[ai][bj][m][1] + b1;
#pragma unroll
                    for (int j = 0; j < 4; ++j) { v0[j] = y0[j] * fast_sigmoid(v0[j]); v1[j] = y1[j] * fast_sigmoid(v1[j]); }
                    *(pg8::u32x4*)(YM + row * D + col0 + bj * 128) = pack8(v0, v1); asm volatile("" ::: "memory"); } }
    }
};
struct FEpiOut0 {
    static constexpr bool PERM = true;
    const float* X; bf16* R1;
    __device__ __forceinline__ void operator()(const pg8::f32x4 (&acc)[2][2][4][2], const pg8::Unit& u, int wr, int wc, int fr, int fq) const {
        const int row0 = u.pm * 256 + wr * 64 + fr, col0 = u.pn * 256 + wc * 32 + 8 * fq;
#pragma unroll
        for (int ai = 0; ai < 2; ++ai)
#pragma unroll
            for (int m = 0; m < 4; ++m) { const size_t off = (size_t)(row0 + ai * 128 + m * 16) * D + col0;
#pragma unroll
                for (int bj = 0; bj < 2; ++bj) { const pg8::f32x4 x0 = *(const pg8::f32x4*)(X + off + bj * 128), x1 = *(const pg8::f32x4*)(X + off + bj * 128 + 4);
                    *(pg8::u32x4*)(R1 + off + bj * 128) = pack8(x0 * ALPHA + acc[ai][bj][m][0], x1 * ALPHA + acc[ai][bj][m][1]); }
                asm volatile("" ::: "memory"); }
    }
};
struct FEpiZ1 {
    static constexpr bool PERM = true;
    bf16* Z;
    __device__ __forceinline__ void operator()(const pg8::f32x4 (&acc)[2][2][4][2], const pg8::Unit& u, int wr, int wc, int fr, int fq) const {
        const int row0 = u.pm * 256 + wr * 64 + fr, col0 = u.pn * 256 + wc * 32 + 8 * fq; const bool g = u.pn < 5;
#pragma unroll
        for (int ai = 0; ai < 2; ++ai)
#pragma unroll
            for (int m = 0; m < 4; ++m) { bf16* rowp = Z + (size_t)(row0 + ai * 128 + m * 16) * NZ1 + col0;
#pragma unroll
                for (int bj = 0; bj < 2; ++bj) { pg8::f32x4 v0 = acc[ai][bj][m][0], v1 = acc[ai][bj][m][1];
                    if (g) {
#pragma unroll
                        for (int j = 0; j < 4; ++j) { v0[j] = fast_gelu(v0[j]); v1[j] = fast_gelu(v1[j]); } }
                    *(pg8::u32x4*)(rowp + bj * 128) = pack8(v0, v1); }
                asm volatile("" ::: "memory"); }
    }
};
struct FEpiOut1 {
    static constexpr bool PERM = true;
    const bf16* Hb; bf16* R1;
    __device__ __forceinline__ void operator()(const pg8::f32x4 (&acc)[2][2][4][2], const pg8::Unit& u, int wr, int wc, int fr, int fq) const {
        const int row0 = u.pm * 256 + wr * 64 + fr, col0 = u.pn * 256 + wc * 32 + 8 * fq;
#pragma unroll
        for (int ai = 0; ai < 2; ++ai)
#pragma unroll
            for (int m = 0; m < 4; ++m) { const size_t off = (size_t)(row0 + ai * 128 + m * 16) * D + col0;
#pragma unroll
                for (int bj = 0; bj < 2; ++bj) { pg8::f32x4 h0, h1; unpack8(*(const pg8::u32x4*)(Hb + off + bj * 128), h0, h1);
                    *(pg8::u32x4*)(R1 + off + bj * 128) = pack8(h0 * ALPHA + acc[ai][bj][m][0], h1 * ALPHA + acc[ai][bj][m][1]); }
                asm volatile("" ::: "memory"); }
    }
};

template <bool GATHER_, int NTN, int KK, int BROWS>
struct MoeOrder {
    static constexpr bool GATHER = GATHER_;
    const char* A; const char* Bt; const int* list; const int* cnt; const volatile LAS int* tp; int G, c, total;
    __device__ bool next(int i, pg8::Unit& u) const {
        const long L = (long)i * G + c; if (L >= total) return false;
        const int gt = (int)(L / NTN), pn = (int)(L % NTN);
        int e = 0;
#pragma unroll 1
        for (int k = 16; k >= 1; k >>= 1) if (__builtin_amdgcn_readfirstlane(tp[e + k]) <= gt) e += k;
        const int mt = gt - __builtin_amdgcn_readfirstlane(tp[e]);
        u.pm = gt; u.pn = pn; u.ex = e | (mt << 8); { const int left = cnt[CNT_IDX(e)] - mt * 256; u.nrow = left < 256 ? left : 256; }
        u.a = GATHER ? A : A + (size_t)gt * 256 * KK * 2; u.b = Bt + ((size_t)e * BROWS + (size_t)pn * 256) * KK * 2; return true;
    }
    __device__ __forceinline__ void voffs(const pg8::Unit& u, int tid, unsigned (&v0)[2], unsigned (&v1)[2]) const {
        const int e = u.ex & 255, mt = u.ex >> 8; const int* lp = list + (size_t)e * LIST_CAP + mt * 256;
#pragma unroll
        for (int i = 0; i < 2; ++i) { int R, C; pg8::stage_rc(tid * 16 + i * 8192, R, C);
            const int t0 = R < u.nrow ? (lp[R] >> 1) : 0, t1 = (R + 128) < u.nrow ? (lp[R + 128] >> 1) : 0;
            v0[i] = (unsigned)(t0 * KK + C) * 2u; v1[i] = (unsigned)(t1 * KK + C) * 2u; }
    }
};
struct FEpiMoe1 {
    static constexpr bool PERM = true;
    bf16* HID;
    __device__ __forceinline__ void operator()(const pg8::f32x4 (&acc)[2][2][4][2], const pg8::Unit& u, int wr, int wc, int fr, int fq) const {
        const int row0 = u.pm * 256 + wr * 64 + fr, col0 = u.pn * 128 + wc * 32 + 8 * fq;
#pragma unroll
        for (int ai = 0; ai < 2; ++ai)
#pragma unroll
            for (int m = 0; m < 4; ++m) { pg8::f32x4 v0, v1;
#pragma unroll
                for (int j = 0; j < 4; ++j) { const float g0 = acc[ai][0][m][0][j], g1 = acc[ai][0][m][1][j];
                    v0[j] = g0 * fast_sigmoid(g0) * acc[ai][1][m][0][j]; v1[j] = g1 * fast_sigmoid(g1) * acc[ai][1][m][1][j]; }
                *(pg8::u32x4*)(HID + (size_t)(row0 + ai * 128 + m * 16) * 512 + col0) = pack8(v0, v1); }
    }
};
struct FEpiMoe2 {
    static constexpr bool PERM = true;
    bf16* Y2; const int* list; const float* gate;
    __device__ __forceinline__ void operator()(const pg8::f32x4 (&acc)[2][2][4][2], const pg8::Unit& u, int wr, int wc, int fr, int fq) const {
        const int e = u.ex & 255, mt = u.ex >> 8; const int* lp = list + (size_t)e * LIST_CAP + mt * 256;
        const int col0 = u.pn * 256 + wc * 32 + 8 * fq;
#pragma unroll
        for (int ai = 0; ai < 2; ++ai)
#pragma unroll
            for (int m = 0; m < 4; ++m) { const int r = ai * 128 + wr * 64 + m * 16 + fr;
                if (r < u.nrow) { const int asg = lp[r]; const float gt = gate[asg]; bf16* rowp = Y2 + (size_t)asg * D + col0;
#pragma unroll
                    for (int bj = 0; bj < 2; ++bj) *(pg8::u32x4*)(rowp + bj * 128) = pack8(acc[ai][bj][m][0] * gt, acc[ai][bj][m][1] * gt); } }
    }
};
__device__ __forceinline__ int moe_prefix(const int* cnt, volatile LAS int* tp, int tid) {
    if (tid == 0) { int acc = 0; for (int e = 0; e < NE; ++e) { tp[e] = acc; acc += (cnt[CNT_IDX(e)] + 255) >> 8; } tp[NE] = acc; }
    __syncthreads();
    return __builtin_amdgcn_readfirstlane(tp[NE]);
}


__device__ __forceinline__ void load16bf(const bf16* ptr, float (&v)[16]) {
    const pg8::u32x4 a = *(const pg8::u32x4*)ptr, b = *(const pg8::u32x4*)(ptr + 8);
    pg8::f32x4 x0, x1, x2, x3; unpack8(a, x0, x1); unpack8(b, x2, x3);
#pragma unroll
    for (int j = 0; j < 4; ++j) { v[j] = x0[j]; v[4 + j] = x1[j]; v[8 + j] = x2[j]; v[12 + j] = x3[j]; }
}
__device__ __forceinline__ void store16bf(bf16* ptr, const float (&v)[16]) {
    pg8::u32x4 a, b;
    a.x = pk2(v[0], v[1]); a.y = pk2(v[2], v[3]); a.z = pk2(v[4], v[5]); a.w = pk2(v[6], v[7]);
    b.x = pk2(v[8], v[9]); b.y = pk2(v[10], v[11]); b.z = pk2(v[12], v[13]); b.w = pk2(v[14], v[15]);
    *(pg8::u32x4*)ptr = a; *(pg8::u32x4*)(ptr + 8) = b;
}
__device__ __forceinline__ void ln16(float (&v)[16], const float* g, const float* b, int c0) {
    float s = 0.f;
#pragma unroll
    for (int j = 0; j < 16; ++j) s += v[j];
    const float mean = wave_sum(s) * (1.f / D); float q = 0.f;
#pragma unroll
    for (int j = 0; j < 16; ++j) { v[j] -= mean; q += v[j] * v[j]; }
    const float rstd = 1.f / sqrtf(wave_sum(q) * (1.f / D) + LN_EPS);
#pragma unroll
    for (int j4 = 0; j4 < 4; ++j4) { const pg8::f32x4 gg = *(const pg8::f32x4*)(g + c0 + 4 * j4), bb = *(const pg8::f32x4*)(b + c0 + 4 * j4);
#pragma unroll
        for (int j = 0; j < 4; ++j) v[4 * j4 + j] = v[4 * j4 + j] * rstd * gg[j] + bb[j]; }
}
constexpr size_t WB_WR = 19 * MiB + 576 * 1024;
__device__ __forceinline__ void router_table(const P& p, int gt, int NGT) {
    for (int it = gt; it < 2 * 48 * 1024; it += NGT) {
        const int L = it / (48 * 1024), r = it % (48 * 1024), c = r >> 10, k = r & 1023;
        float w = 0.f;
        if (c < 4) w = (L ? p.in[I_M1WC] : p.in[I_M0WC])[(size_t)k * 4 + c];
        else if (c < 36) w = (L ? p.in[I_M1WF] : p.in[I_M0WF])[((size_t)((c - 4) >> 3) * D + k) * 8 + ((c - 4) & 7)];
        const bf16 hi = f2bf(w); const bf16 lo = f2bf(w - bf2f(hi));
        bf16* T = (bf16*)(p.ws + WB_WR) + (size_t)L * 96 * 1024;
        T[(size_t)c * 1024 + k] = hi; T[(size_t)(48 + c) * 1024 + k] = lo;
    }
}
template <int L> __device__ __forceinline__ void router_phase(const Frame& F, const P& p, int gw, int NGW, LAS unsigned char* lds, CArgsF* qk) {
    const bf16* R1 = (const bf16*)(p.ws + WS_R1); bf16* Hb = (bf16*)(p.ws + WS_HB);
    const float* g = p.in[L ? I_L1LN1G : I_L0LN1G]; const float* bb = p.in[L ? I_L1LN1B : I_L0LN1B];
    const float* bc = p.in[L ? I_M1BC : I_M0BC]; const float* bfi = p.in[L ? I_M1BF : I_M0BF];
    const bf16* WR = (const bf16*)(p.ws + WB_WR) + (size_t)L * 96 * 1024;
    int* cnt = (int*)(p.ws + WS_CTL) + (L ? CW_CNT1 : CW_CNT0);
    int* list = (int*)(p.ws + WS_ROUTE); float* gate = (float*)(p.ws + WS_GATE);
    LAS int* lcnt = (LAS int*)lds; LAS int* lbase = lcnt + 32; LAS int* ent = lcnt + 64;
    LAS float* st = (LAS float*)(lds + 2048);
    LAS float* lgp = (LAS float*)(lds + 8192);
    const int lane = F.lane, row = lane & 15, kq = lane >> 4, wv = F.wave;
#pragma unroll 1
    for (int grp64 = F.vcu; grp64 < (MR + 63) / 64; grp64 += F.G) {
        const int r0 = grp64 * 64, nt4 = (MR - r0) >= 64 ? 4 : (MR - r0) / 16;
        if (F.tid < 32) lcnt[F.tid] = 0;
        float s[4], q[4];
#pragma unroll
        for (int t = 0; t < 4; ++t) { s[t] = 0.f; q[t] = 0.f;
            const size_t r = (size_t)r0 + 16 * (t < nt4 ? t : 0) + row;
#pragma unroll
            for (int ks = 0; ks < 4; ++ks) { pg8::f32x4 a, b2; unpack8(*(const pg8::u32x4*)(R1 + r * D + 128 * wv + 32 * ks + 8 * kq), a, b2);
#pragma unroll
                for (int e = 0; e < 4; ++e) { s[t] += a[e] + b2[e]; q[t] += a[e] * a[e] + b2[e] * b2[e]; } }
            s[t] += __shfl_xor(s[t], 16); s[t] += __shfl_xor(s[t], 32); q[t] += __shfl_xor(q[t], 16); q[t] += __shfl_xor(q[t], 32);
            if (kq == 0) { st[(wv * 64 + 16 * t + row) * 2] = s[t]; st[(wv * 64 + 16 * t + row) * 2 + 1] = q[t]; }
        }
        bf16x8 bw[6][4];
#pragma unroll
        for (int nt = 0; nt < 6; ++nt)
#pragma unroll
            for (int ks = 0; ks < 4; ++ks) bw[nt][ks] = *(const bf16x8*)(WR + (size_t)(16 * nt + row) * 1024 + 128 * wv + 32 * ks + 8 * kq);
        __syncthreads();
#pragma unroll
        for (int t = 0; t < 4; ++t) {
            float ss = 0.f, qq = 0.f;
#pragma unroll
            for (int w = 0; w < 8; ++w) { ss += st[(w * 64 + 16 * t + row) * 2]; qq += st[(w * 64 + 16 * t + row) * 2 + 1]; }
            const float mean = ss * (1.f / D), rstd = 1.f / sqrtf(fmaxf(qq * (1.f / D) - mean * mean, 0.f) + LN_EPS);
            const size_t r = (size_t)r0 + 16 * (t < nt4 ? t : 0) + row;
            f32x4 acc[6];
#pragma unroll
            for (int nt = 0; nt < 6; ++nt) acc[nt] = (f32x4){0.f, 0.f, 0.f, 0.f};
#pragma unroll
            for (int ks = 0; ks < 4; ++ks) {
                const int c0 = 128 * wv + 32 * ks + 8 * kq;
                pg8::f32x4 a, b2; unpack8(*(const pg8::u32x4*)(R1 + r * D + c0), a, b2);
                const pg8::f32x4 g0 = *(const pg8::f32x4*)(g + c0), g1 = *(const pg8::f32x4*)(g + c0 + 4), o0 = *(const pg8::f32x4*)(bb + c0), o1 = *(const pg8::f32x4*)(bb + c0 + 4);
                a = (a - mean) * rstd * g0 + o0; b2 = (b2 - mean) * rstd * g1 + o1;
                const pg8::u32x4 hw = pack8(a, b2);
                if (t < nt4) *(pg8::u32x4*)(Hb + r * D + c0) = hw;
                const bf16x8 af = __builtin_bit_cast(bf16x8, hw);
#pragma unroll
                for (int nt = 0; nt < 6; ++nt) acc[nt] = __builtin_amdgcn_mfma_f32_16x16x32_bf16(af, bw[nt][ks], acc[nt], 0, 0, 0);
            }
#pragma unroll
            for (int nt = 0; nt < 3; ++nt)
#pragma unroll
                for (int e = 0; e < 4; ++e) lgp[(wv * 64 + 16 * t + 4 * kq + e) * 48 + 16 * nt + row] = acc[nt][e] + acc[nt + 3][e];
        }
        __syncthreads();
        { const int rr = F.tid >> 3, j0 = 6 * (F.tid & 7);
#pragma unroll
          for (int j = 0; j < 6; ++j) { if (j0 + j < 36) { float a = 0.f;
#pragma unroll
              for (int w = 0; w < 8; ++w) a += lgp[(w * 64 + rr) * 48 + j0 + j];
              lgp[rr * 48 + j0 + j] = a; } } }
        __syncthreads();
        if (F.tid < 16 * nt4) {
            const LAS float* lr = lgp + F.tid * 48; const int rr = r0 + F.tid;
            float lc[4];
#pragma unroll
            for (int c4 = 0; c4 < 4; ++c4) lc[c4] = lr[c4] + bc[c4];
            int grp = 0; float mxc = lc[0];
#pragma unroll
            for (int c4 = 1; c4 < 4; ++c4) if (lc[c4] > mxc) { mxc = lc[c4]; grp = c4; }
            float se = 0.f;
#pragma unroll
            for (int c4 = 0; c4 < 4; ++c4) se += expf(lc[c4] - mxc);
            const float pgrp = 1.f / se;
            float lf[8];
#pragma unroll
            for (int e8 = 0; e8 < 8; ++e8) lf[e8] = lr[4 + grp * 8 + e8] + bfi[grp * 8 + e8];
            int i0 = 0; float v0 = lf[0];
#pragma unroll
            for (int e8 = 1; e8 < 8; ++e8) if (lf[e8] > v0) { v0 = lf[e8]; i0 = e8; }
            int i1 = 0; float v1 = -1e30f;
#pragma unroll
            for (int e8 = 0; e8 < 8; ++e8) if (e8 != i0 && lf[e8] > v1) { v1 = lf[e8]; i1 = e8; }
            const float e1 = expf(v1 - v0); const float g0 = pgrp / (1.f + e1), g1 = pgrp * e1 / (1.f + e1);
            const int ea = grp * 8 + i0, eb = grp * 8 + i1;
            const int pa = __hip_atomic_fetch_add(lcnt + ea, 1, __ATOMIC_RELAXED, __HIP_MEMORY_SCOPE_WORKGROUP);
            const int pb = __hip_atomic_fetch_add(lcnt + eb, 1, __ATOMIC_RELAXED, __HIP_MEMORY_SCOPE_WORKGROUP);
            LAS int* en = ent + F.tid * 4; en[0] = ea; en[1] = pa; en[2] = eb; en[3] = pb;
            gate[rr * 2] = g0; gate[rr * 2 + 1] = g1;
        }
        __syncthreads();
        if (F.tid < 32) { const int c = lcnt[F.tid]; lbase[F.tid] = c ? atomicAdd(&cnt[CNT_IDX(F.tid)], c) : 0; }
        __syncthreads();
        if (F.tid < 16 * nt4) { const LAS int* en = ent + F.tid * 4; const int rr = r0 + F.tid;
            list[(size_t)en[0] * LIST_CAP + lbase[en[0]] + en[1]] = rr * 2; list[(size_t)en[2] * LIST_CAP + lbase[en[2]] + en[3]] = rr * 2 + 1; }
        __syncthreads();
    }
}
template <int L> __device__ __forceinline__ void combine_phase(const Frame& F, const P& p, int gw, int NGW) {
    bf16* Hb = (bf16*)(p.ws + WS_HB); const bf16* Y2 = (const bf16*)(p.ws + WS_Z);
    const float* g = p.in[L ? I_L1LN2G : I_L0LN2G]; const float* bb = p.in[L ? I_L1LN2B : I_L0LN2B];
    const int lane = F.lane, c0 = lane * 16;
    for (int r = gw; r < (L ? MX : MR); r += NGW) {
        float v[16], a[16], b[16]; load16bf(Hb + (size_t)r * D + c0, v); load16bf(Y2 + (size_t)(2 * r) * D + c0, a); load16bf(Y2 + (size_t)(2 * r + 1) * D + c0, b);
#pragma unroll
        for (int j = 0; j < 16; ++j) v[j] = ALPHA * v[j] + a[j] + b[j];
        ln16(v, g, bb, c0);
        if (L == 0) store16bf(Hb + (size_t)r * D + c0, v);
        else {
#pragma unroll
            for (int j4 = 0; j4 < 4; ++j4) *(pg8::f32x4*)(p.out + (size_t)r * D + c0 + 4 * j4) = (pg8::f32x4){v[4 * j4], v[4 * j4 + 1], v[4 * j4 + 2], v[4 * j4 + 3]};
        }
    }
}

namespace att {
typedef float f32x16 __attribute__((ext_vector_type(16)));
typedef short s16x4 __attribute__((ext_vector_type(4)));
typedef short v4i16_t __attribute__((ext_vector_type(4)));
constexpr int KS = 144, KBYTES = 64 * KS;
constexpr int VS = 320, VBYTES = 64 * VS;
constexpr int STG = 2 * KBYTES + VBYTES;
constexpr float THR = 6.0f;
__device__ __forceinline__ int crow(int r, int hi) { return (r & 3) + 8 * (r >> 2) + 4 * hi; }
__device__ __forceinline__ s16x4 vtr(const LAS unsigned char* p) { return __builtin_bit_cast(s16x4, __builtin_amdgcn_ds_read_tr16_b64_v4i16((LAS v4i16_t*)p)); }

__device__ __forceinline__ void attn_unit(const Frame& F, const P& p, LAS unsigned char* lds, int b, int h, int qb, bool is_meta, float lam, int abl) {
    const bf16* Z = (const bf16*)(p.ws + WS_Z); bf16* YM = (bf16*)(p.ws + WS_YM);
    const int tid = F.tid, lane = F.lane, wid = F.wave, qsub = wid & 3, c = wid >> 2, r32 = lane & 31, hi = lane >> 5;
    const bool wave_active = is_meta ? (qsub == 0) : true;
    const int ntiles = is_meta ? 1 : 2 * qb + 3;
    const int my_ntiles = !wave_active ? 0 : (is_meta ? 1 : 2 * qb + 2 + (qsub >= 2 ? 1 : 0));
    const size_t qrow = is_meta ? (size_t)(MX + (r32 < 16 ? r32 : 15)) : (size_t)b * SEQ + qb * 128 + qsub * 32 + r32;
    bf16x8 qf[4];
#pragma unroll
    for (int d = 0; d < 4; ++d) qf[d] = *(const bf16x8*)(Z + qrow * NZ0 + 512 + h * 128 + c * 64 + d * 16 + hi * 8);
    v4u kregA[2], vregA[2];
    auto gload = [&](int t, v4u (&kreg)[2], v4u (&vreg)[2]) {
#pragma unroll
        for (int i = 0; i < 2; ++i) { const int id = tid + 512 * i, row = id >> 4, ch = id & 15;
            long grow = t == 0 ? (row < 16 ? (long)(MX + row) : -1L) : (long)b * SEQ + 64 * (t - 1) + row;
            if (grow >= 0) { kreg[i] = *(const v4u*)(Z + (size_t)grow * NZ0 + 1024 + h * 128 + ch * 8); vreg[i] = *(const v4u*)(Z + (size_t)grow * NZ0 + 1536 + h * 128 + ch * 8); }
            else { kreg[i] = (v4u){0u, 0u, 0u, 0u}; vreg[i] = (v4u){0u, 0u, 0u, 0u}; } }
    };
    auto sstore = [&](int kslot, int vslot, const v4u (&kreg)[2], const v4u (&vreg)[2]) {
#pragma unroll
        for (int i = 0; i < 2; ++i) { const int id = tid + 512 * i, row = id >> 4, ch = id & 15;
            *(LAS v4u*)(lds + kslot * 2 * KBYTES + (ch >> 3) * KBYTES + row * KS + (ch & 7) * 16) = kreg[i];
            *(LAS v4u*)(lds + 4 * KBYTES + vslot * VBYTES + row * VS + ch * 16) = vreg[i]; }
    };
    f32x16 o[4];
#pragma unroll
    for (int d = 0; d < 4; ++d) o[d] = f32x16{};
    float m = -1e30f, l = 0.f;
    bf16x8 pa[4];
#pragma unroll
    for (int s2 = 0; s2 < 4; ++s2) pa[s2] = (bf16x8){0, 0, 0, 0, 0, 0, 0, 0};
    auto qk_softmax = [&](int t, int kslot) {
        const LAS unsigned char* Kc = lds + kslot * 2 * KBYTES + c * KBYTES + r32 * KS + hi * 16;
        f32x16 p0 = f32x16{}, p1 = f32x16{};
        { bf16x8 kf[8];
#pragma unroll
          for (int d = 0; d < 4; ++d) { kf[2 * d] = *(const LAS bf16x8*)(Kc + d * 32); kf[2 * d + 1] = *(const LAS bf16x8*)(Kc + 32 * KS + d * 32); }
#pragma unroll
          for (int d = 0; d < 4; ++d) {
            p0 = __builtin_amdgcn_mfma_f32_32x32x16_bf16(kf[2 * d], qf[d], p0, 0, 0, 0);
            p1 = __builtin_amdgcn_mfma_f32_32x32x16_bf16(kf[2 * d + 1], qf[d], p1, 0, 0, 0); } }
        __builtin_amdgcn_sched_barrier(0);
        if (t == 0) {
#pragma unroll
            for (int r = 0; r < 16; ++r) { if (r >= 8) p0[r] = -1e30f; p1[r] = -1e30f; }
        }
        float rm = fmaxf(p0[0], p1[0]);
#pragma unroll
        for (int r = 1; r < 16; ++r) rm = fmaxf(rm, fmaxf(p0[r], p1[r]));
        rm = fmaxf(rm, __shfl_xor(rm, 32));
        if (__any(rm > m + THR)) {
            const float mn = fmaxf(m, rm), alpha = __builtin_amdgcn_exp2f(m - mn);
            m = mn; l *= alpha;
#pragma unroll
            for (int r = 0; r < 16; ++r) { const float ar = __shfl(alpha, crow(r, hi));
#pragma unroll
                for (int d = 0; d < 4; ++d) o[d][r] *= ar; }
        }
        float ls = 0.f;
#pragma unroll
        for (int r = 0; r < 16; ++r) { p0[r] = __builtin_amdgcn_exp2f(p0[r] - m); p1[r] = __builtin_amdgcn_exp2f(p1[r] - m); ls += p0[r] + p1[r]; }
        l += ls;
        { v4u w;
          w.x = pg8::cvt_pk_bf16(p0[0], p0[1]); w.y = pg8::cvt_pk_bf16(p0[2], p0[3]); w.z = pg8::cvt_pk_bf16(p0[4], p0[5]); w.w = pg8::cvt_pk_bf16(p0[6], p0[7]); pa[0] = __builtin_bit_cast(bf16x8, w);
          w.x = pg8::cvt_pk_bf16(p0[8], p0[9]); w.y = pg8::cvt_pk_bf16(p0[10], p0[11]); w.z = pg8::cvt_pk_bf16(p0[12], p0[13]); w.w = pg8::cvt_pk_bf16(p0[14], p0[15]); pa[1] = __builtin_bit_cast(bf16x8, w);
          w.x = pg8::cvt_pk_bf16(p1[0], p1[1]); w.y = pg8::cvt_pk_bf16(p1[2], p1[3]); w.z = pg8::cvt_pk_bf16(p1[4], p1[5]); w.w = pg8::cvt_pk_bf16(p1[6], p1[7]); pa[2] = __builtin_bit_cast(bf16x8, w);
          w.x = pg8::cvt_pk_bf16(p1[8], p1[9]); w.y = pg8::cvt_pk_bf16(p1[10], p1[11]); w.z = pg8::cvt_pk_bf16(p1[12], p1[13]); w.w = pg8::cvt_pk_bf16(p1[14], p1[15]); pa[3] = __builtin_bit_cast(bf16x8, w); }
        __builtin_amdgcn_sched_barrier(0);
    };
    auto pv = [&](int vslot) {
        const LAS unsigned char* Vb = lds + 4 * KBYTES + vslot * VBYTES + (4 * hi + ((lane & 15) >> 2)) * VS + (16 * ((lane >> 4) & 1) + 4 * (lane & 3)) * 2;
        s16x4 va[8], vb[8];
#define LDV(dst, d) do { _Pragma("unroll") for (int s = 0; s < 4; ++s) { dst[2 * s] = vtr(Vb + (16 * s) * VS + (d) * 64); dst[2 * s + 1] = vtr(Vb + (16 * s + 8) * VS + (d) * 64); } } while (0)
#define PVM(src, d) do { _Pragma("unroll") for (int s = 0; s < 4; ++s) { const bf16x8 vf = (bf16x8){src[2 * s][0], src[2 * s][1], src[2 * s][2], src[2 * s][3], src[2 * s + 1][0], src[2 * s + 1][1], src[2 * s + 1][2], src[2 * s + 1][3]}; \
            o[d] = __builtin_amdgcn_mfma_f32_32x32x16_bf16(pa[s], vf, o[d], 0, 0, 0); } } while (0)
        LDV(va, 0); __builtin_amdgcn_sched_barrier(0);
        LDV(vb, 1); PVM(va, 0); __builtin_amdgcn_sched_barrier(0);
        LDV(va, 2); PVM(vb, 1); __builtin_amdgcn_sched_barrier(0);
        LDV(vb, 3); PVM(va, 2); __builtin_amdgcn_sched_barrier(0);
        PVM(vb, 3);
#undef LDV
#undef PVM
    };
    gload(0, kregA, vregA); sstore(0, 0, kregA, vregA);
    __syncthreads();
    int vs = 0;
#pragma unroll 1
    for (int t = 0; t < ntiles; ++t) {
        const int vs1 = vs == 2 ? 0 : vs + 1; const bool more = t + 1 < ntiles;
        if (more && !(abl & 4)) gload(t + 1, kregA, vregA);
        if (t < my_ntiles && !(abl & 1)) qk_softmax(t, t & 1);
        if (c == 1) { if (more && !(abl & 4)) sstore((t + 1) & 1, vs1, kregA, vregA); __syncthreads(); }
        if (t < my_ntiles && !(abl & 3)) pv(vs);
        if (c == 0) { if (more && !(abl & 4)) sstore((t + 1) & 1, vs1, kregA, vregA); __syncthreads(); }
        vs = vs1;
    }
    __syncthreads();
    const float lt = l + __shfl_xor(l, 32);
    const float inv = (c == 1 ? lam : 1.f) / lt;
#pragma unroll
    for (int r = 0; r < 16; ++r) { const float ir = __shfl(inv, crow(r, hi));
#pragma unroll
        for (int d = 0; d < 4; ++d) o[d][r] *= ir; }
    LAS float* ex = (LAS float*)(lds) + qsub * 4224;
    if (c == 1 && wave_active) {
#pragma unroll
        for (int d = 0; d < 4; ++d)
#pragma unroll
            for (int r = 0; r < 16; ++r) ex[(d * 16 + r) * 64 + lane] = o[d][r];
    }
    __syncthreads();
    if (c == 0 && wave_active) {
#pragma unroll
        for (int d = 0; d < 4; ++d)
#pragma unroll
            for (int r = 0; r < 16; ++r) o[d][r] -= ex[(d * 16 + r) * 64 + lane];
        LDS_WAIT(); asm volatile("" ::: "memory");
#pragma unroll
        for (int d = 0; d < 4; ++d)
#pragma unroll
            for (int r = 0; r < 16; ++r) ex[(4 * hi) * 132 + r32 + ((r & 3) + 8 * (r >> 2)) * 132 + 32 * d] = o[d][r];
        LDS_WAIT(); asm volatile("" ::: "memory");
        const int q = r32, half = hi;
        float ss = 0.f;
#pragma unroll
        for (int k = 0; k < 16; ++k) { const pg8::f32x4 x = *(const LAS pg8::f32x4*)(ex + q * 132 + 64 * half + 4 * k);
            ss += (x[0] * x[0] + x[1] * x[1]) + (x[2] * x[2] + x[3] * x[3]); }
        ss += __shfl_xor(ss, 32);
        const float rs = (1.f - LAM_INIT) / sqrtf(ss * (1.f / 128.f) + LN_EPS);
        const float* sg = p.in[I_SUBLN] + 64 * half;
        const size_t orow = is_meta ? (size_t)(MX + q) : (size_t)b * SEQ + qb * 128 + qsub * 32 + q;
        if (!is_meta || q < 16) {
            bf16* op = YM + orow * D + 512 + h * 128 + 64 * half;
#pragma unroll
            for (int k = 0; k < 8; ++k) { const pg8::f32x4 g0 = *(const pg8::f32x4*)(sg + 8 * k), g1 = *(const pg8::f32x4*)(sg + 8 * k + 4);
                const pg8::f32x4 x0 = *(const LAS pg8::f32x4*)(ex + q * 132 + 64 * half + 8 * k);
                const pg8::f32x4 x1 = *(const LAS pg8::f32x4*)(ex + q * 132 + 64 * half + 8 * k + 4);
                *(pg8::u32x4*)(op + 8 * k) = pack8(x0 * g0 * rs, x1 * g1 * rs);
                asm volatile("" ::: "memory"); }
        }
    }
    __syncthreads();
}

__device__ __forceinline__ void attn_phase(const Frame& F, const P& p, LAS unsigned char* lds, int abl = 0) {
    const float l1 = wave_sum(p.in[I_LQ1][F.lane] * p.in[I_LK1][F.lane]);
    const float l2 = wave_sum(p.in[I_LQ2][F.lane] * p.in[I_LK2][F.lane]);
    const float lam = expf(l1) - expf(l2) + LAM_INIT;
    const int npair = (F.vcu < 256) ? 1 : 0;
    const int nun = 2 * npair + (F.vcu < 4 ? 1 : 0);
#pragma unroll 1
    for (int u = 0; u < nun; ++u) {
        const int pr = F.vcu, bh = pr >> 3, s = pr & 7;
        const bool is_meta = (u == 2 * npair);
        const int b = is_meta ? 0 : (bh >> 2), h = is_meta ? F.vcu : (bh & 3), qb = is_meta ? 0 : (u == 0 ? 15 - s : s);
        attn_unit(F, p, lds, b, h, qb, is_meta, lam, abl);
    }
}
}
namespace lru {
constexpr size_t WS_XC = WS_MOE0;
__device__ __forceinline__ size_t seq_row(int b, int s) { return s < NMETA ? (size_t)(MX + s) : (size_t)b * SEQ + (s - NMETA); }

__device__ __forceinline__ void conv_phase(const Frame& F, const P& p) {
    const bf16* Z = (const bf16*)(p.ws + WS_Z); bf16* XC = (bf16*)(p.ws + WS_XC);
    const float* cw = p.in[I_CONVW]; const float* cb = p.in[I_CONVB];
    const int gt = (F.vcu * NWAVES + F.wave) * 64 + F.lane, NGT = F.G * NWAVES * 64;
    for (int it = gt; it < 513 * 160; it += NGT) {
        const int seg = it / 160, c8 = (it % 160) * 8;
        const int b = seg < 512 ? seg >> 6 : 0, s0 = seg < 512 ? NMETA + 32 * (seg & 63) : 0, len = seg < 512 ? 32 : NMETA;
        float w[4][8], bias[8];
#pragma unroll
        for (int j = 0; j < 4; ++j) { const pg8::f32x4 w0 = *(const pg8::f32x4*)(cw + j * DRNN + c8), w1 = *(const pg8::f32x4*)(cw + j * DRNN + c8 + 4);
#pragma unroll
            for (int e2 = 0; e2 < 4; ++e2) { w[j][e2] = w0[e2]; w[j][4 + e2] = w1[e2]; } }
        { const pg8::f32x4 b0 = *(const pg8::f32x4*)(cb + c8), b1 = *(const pg8::f32x4*)(cb + c8 + 4);
#pragma unroll
          for (int e2 = 0; e2 < 4; ++e2) { bias[e2] = b0[e2]; bias[4 + e2] = b1[e2]; } }
        pg8::f32x4 h0[3], h1[3];
#pragma unroll
        for (int j = 0; j < 3; ++j) { const int sj = s0 - 3 + j;
            if (sj >= 0) unpack8(*(const pg8::u32x4*)(Z + seq_row(b, sj) * NZ1 + DRNN + c8), h0[j], h1[j]);
            else { h0[j] = (pg8::f32x4){0.f, 0.f, 0.f, 0.f}; h1[j] = (pg8::f32x4){0.f, 0.f, 0.f, 0.f}; } }
#pragma unroll 4
        for (int i = 0; i < len; ++i) {
            const size_t row = seq_row(b, s0 + i);
            pg8::f32x4 x0, x1; unpack8(*(const pg8::u32x4*)(Z + row * NZ1 + DRNN + c8), x0, x1);
            pg8::f32x4 o0, o1;
#pragma unroll
            for (int e2 = 0; e2 < 4; ++e2) {
                o0[e2] = bias[e2] + h0[0][e2] * w[0][e2] + h0[1][e2] * w[1][e2] + h0[2][e2] * w[2][e2] + x0[e2] * w[3][e2];
                o1[e2] = bias[4 + e2] + h1[0][e2] * w[0][4 + e2] + h1[1][e2] * w[1][4 + e2] + h1[2][e2] * w[2][4 + e2] + x1[e2] * w[3][4 + e2]; }
            *(pg8::u32x4*)(XC + row * DRNN + c8) = pack8(o0, o1);
            h0[0] = h0[1]; h0[1] = h0[2]; h0[2] = x0; h1[0] = h1[1]; h1[1] = h1[2]; h1[2] = x1;
        }
    }
}

__device__ __forceinline__ void scan_unit(const Frame& F, const P& p, int b, int n, int j) {
    const bf16* Z = (const bf16*)(p.ws + WS_Z); const bf16* XC = (const bf16*)(p.ws + WS_XC); bf16* Y1 = (bf16*)(p.ws + WS_YM);
    const bf16* WAX = (const bf16*)(p.ws + WB_WAX);
    const int lane = F.lane, col = lane & 15, grp = lane >> 4, ch = n * 128 + 16 * j + col;
    bf16x8 bw[2][4];
#pragma unroll
    for (int g = 0; g < 2; ++g)
#pragma unroll
        for (int ks = 0; ks < 4; ++ks) bw[g][ks] = *(const bf16x8*)(WAX + ((size_t)(n * 2 + g) * 128 + 16 * j + col) * 128 + 32 * ks + 8 * grp);
    bf16x8 ident;
    { const int kl = 16 * (j & 1) + col;
#pragma unroll
      for (int e = 0; e < 8; ++e) ident[e] = (grp == (kl >> 3) && e == (kl & 7)) ? (short)0x3F80 : (short)0; }
    const float ba = p.in[I_BA][ch], bx = p.in[I_BX][ch];
    const float lam = p.in[I_LAM][ch];
    const float c8 = -8.f * log1pf(expf(-lam)) * 1.4426950408889634f;
    float carry = 0.f;
    const int ksx = j >> 1;
    bf16x8 xa[2][4], ga[2];
    auto ldtile = [&](int T, bf16x8 (&x)[2][4], bf16x8 (&gq)[2]) {
#pragma unroll
        for (int mt = 0; mt < 2; ++mt) {
            int s = 32 * T + 16 * mt + col; if (s > NMETA + SEQ - 1) s = NMETA + SEQ - 1;
            const size_t row = seq_row(b, s);
#pragma unroll
            for (int ks = 0; ks < 4; ++ks) x[mt][ks] = *(const bf16x8*)(XC + row * DRNN + n * 128 + 32 * ks + 8 * grp);
            gq[mt] = *(const bf16x8*)(Z + row * NZ1 + n * 128 + 32 * ksx + 8 * grp);
        }
    };
    ldtile(0, xa, ga);
#pragma unroll 1
    for (int T = 0; T < 65; ++T) {
        bf16x8 xn[2][4], gn[2];
        ldtile(T + 1 < 65 ? T + 1 : T, xn, gn);
        f32x4 accA[2], accX[2], xb[2], gg[2];
#pragma unroll
        for (int mt = 0; mt < 2; ++mt) {
            f32x4 a = {0.f, 0.f, 0.f, 0.f}, x = {0.f, 0.f, 0.f, 0.f};
#pragma unroll
            for (int ks = 0; ks < 4; ++ks) { a = __builtin_amdgcn_mfma_f32_16x16x32_bf16(xa[mt][ks], bw[0][ks], a, 0, 0, 0); x = __builtin_amdgcn_mfma_f32_16x16x32_bf16(xa[mt][ks], bw[1][ks], x, 0, 0, 0); }
            accA[mt] = a; accX[mt] = x;
            const bf16x8 xsel = ksx == 0 ? xa[mt][0] : ksx == 1 ? xa[mt][1] : ksx == 2 ? xa[mt][2] : xa[mt][3];
            xb[mt] = __builtin_amdgcn_mfma_f32_16x16x32_bf16(xsel, ident, (f32x4){0.f, 0.f, 0.f, 0.f}, 0, 0, 0);
            gg[mt] = __builtin_amdgcn_mfma_f32_16x16x32_bf16(ga[mt], ident, (f32x4){0.f, 0.f, 0.f, 0.f}, 0, 0, 0);
        }
        float hl[2][4], Ac[2][4], Aex[2], hex[2], Atot[2], htot[2];
#pragma unroll
        for (int mt = 0; mt < 2; ++mt) {
            float ar = 1.f, hr = 0.f;
#pragma unroll
            for (int k = 0; k < 4; ++k) {
                const int s = 32 * T + 16 * mt + 4 * grp + k;
                const float rg = fast_sigmoid(accA[mt][k] + ba), ig = fast_sigmoid(accX[mt][k] + bx);
                float a = __builtin_amdgcn_exp2f(c8 * rg);
                float bt = __builtin_amdgcn_sqrtf(fmaxf(1.f - a * a, 0.f)) * (ig * xb[mt][k]);
                if (s >= NMETA + SEQ) { a = 1.f; bt = 0.f; }
                hr = a * hr + bt; ar = ar * a; hl[mt][k] = hr; Ac[mt][k] = ar;
            }
            float Ai = ar, hi_ = hr;
            { const float A1 = __shfl_up(Ai, 16), h1 = __shfl_up(hi_, 16); if (grp >= 1) { hi_ = Ai * h1 + hi_; Ai = Ai * A1; } }
            { const float A2 = __shfl_up(Ai, 32), h2 = __shfl_up(hi_, 32); if (grp >= 2) { hi_ = Ai * h2 + hi_; Ai = Ai * A2; } }
            const float Ae = __shfl_up(Ai, 16), he = __shfl_up(hi_, 16);
            Aex[mt] = grp >= 1 ? Ae : 1.f; hex[mt] = grp >= 1 ? he : 0.f;
            Atot[mt] = __shfl(Ai, 48 + col); htot[mt] = __shfl(hi_, 48 + col);
        }
#pragma unroll
        for (int mt = 0; mt < 2; ++mt) {
            const float cin = Aex[mt] * carry + hex[mt];
#pragma unroll
            for (int k = 0; k < 4; ++k) {
                const int s = 32 * T + 16 * mt + 4 * grp + k;
                const float h = hl[mt][k] + Ac[mt][k] * cin;
                if (s < NMETA + SEQ && (s >= NMETA || b == 0)) Y1[seq_row(b, s) * DRNN + ch] = f2bf(gg[mt][k] * h);
            }
            carry = Atot[mt] * carry + htot[mt];
        }
#pragma unroll
        for (int mt = 0; mt < 2; ++mt) { ga[mt] = gn[mt];
#pragma unroll
            for (int ks = 0; ks < 4; ++ks) xa[mt][ks] = xn[mt][ks]; }
    }
}
__device__ __forceinline__ void scan_phase(const Frame& F, const P& p) {
    const int gw = F.vcu * NWAVES + F.wave, NGW = F.G * NWAVES;
    for (int u = gw; u < 640 * 3; u += NGW) { if (u % 3) continue; const int id = u / 3; scan_unit(F, p, id / 80, (id % 80) / 8, id % 8); }
}
}
namespace s5 {
typedef float f32x16 __attribute__((ext_vector_type(16)));
constexpr size_t T_K = 19 * MiB, T_A = 19 * MiB + 512 * 1024, T_Q = 20 * MiB, T_P = 24 * MiB;
constexpr int L_U = 0, L_K = 65536, L_E = 81920, L_S = 114688;
__device__ __forceinline__ int crow(int r, int hi) { return (r & 3) + 8 * (r >> 2) + 4 * hi; }

struct Disc { float lrdt, lidt, ar, ai; float bbr[16], bbi[16]; };
__device__ __forceinline__ void disc(const P& p, int g, int lane, Disc& d) {
    const float dt = expf(p.in[I_LOGDT][g]);
    const float lr = fminf(p.in[I_LRE][g * 64 + lane], -1e-4f), li = p.in[I_LIM][g * 64 + lane];
    d.lrdt = lr * dt; d.lidt = li * dt;
    const float mag = expf(d.lrdt); d.ar = mag * cosf(d.lidt); d.ai = mag * sinf(d.lidt);
    const float den = lr * lr + li * li, nr = d.ar - 1.f, ni = d.ai;
    const float fr = (nr * lr + ni * li) / den, fi = (ni * lr - nr * li) / den;
#pragma unroll
    for (int h = 0; h < 16; ++h) { const float br = p.in[I_BRE][((size_t)g * 64 + lane) * 16 + h], bi = p.in[I_BIM][((size_t)g * 64 + lane) * 16 + h];
        d.bbr[h] = fr * br - fi * bi; d.bbi[h] = fr * bi + fi * br; }
}
__device__ __forceinline__ void table_item(const P& p, int g, int tau, LAS float* scr, int lane) {
    Disc d; disc(p, g, lane, d);
    const float mag = expf(d.lrdt * (float)tau); float sn, cs; sincosf(d.lidt * (float)tau, &sn, &cs);
    const float pr = mag * cs, pi = mag * sn;
    bf16* Kt = (bf16*)(p.ws + T_K); bf16* Qg = (bf16*)(p.ws + T_Q); bf16* Pg = (bf16*)(p.ws + T_P); float* A32 = (float*)(p.ws + T_A);
    if (tau == 32) { A32[(g * 64 + lane) * 2] = pr; A32[(g * 64 + lane) * 2 + 1] = pi; }
    if (tau >= 1) {
#pragma unroll
        for (int h = 0; h < 16; ++h) { const float cr = p.in[I_CRE][((size_t)g * 16 + h) * 64 + lane], ci = p.in[I_CIM][((size_t)g * 16 + h) * 64 + lane];
            bf16* row = Pg + ((size_t)g * 512 + (tau - 1) * 16 + h) * 128;
            row[lane] = f2bf(cr * pr - ci * pi); row[64 + lane] = f2bf(-(cr * pi + ci * pr)); }
    }
    if (tau <= 31) {
        float pbr[16], pbi[16];
#pragma unroll
        for (int h = 0; h < 16; ++h) { pbr[h] = pr * d.bbr[h] - pi * d.bbi[h]; pbi[h] = pr * d.bbi[h] + pi * d.bbr[h]; }
        bf16* qre = Qg + ((size_t)g * 128 + lane) * 512 + (31 - tau) * 16; bf16* qim = Qg + ((size_t)g * 128 + 64 + lane) * 512 + (31 - tau) * 16;
        store16bf(qre, pbr); store16bf(qim, pbi);
#pragma unroll
        for (int h = 0; h < 16; ++h) { scr[lane * 33 + h] = pbr[h]; scr[lane * 33 + 16 + h] = pbi[h]; }
        LDS_WAIT(); asm volatile("" ::: "memory");
        const int h = lane >> 2, hq = (lane & 3) * 4;
        float acc[4] = {0.f, 0.f, 0.f, 0.f};
        const float* crp = p.in[I_CRE] + ((size_t)g * 16 + h) * 64; const float* cip = p.in[I_CIM] + ((size_t)g * 16 + h) * 64;
#pragma unroll 1
        for (int pc = 0; pc < 64; pc += 16) {
            pg8::f32x4 cr4[4], ci4[4];
#pragma unroll
            for (int i = 0; i < 4; ++i) { cr4[i] = *(const pg8::f32x4*)(crp + pc + 4 * i); ci4[i] = *(const pg8::f32x4*)(cip + pc + 4 * i); }
#pragma unroll
            for (int i = 0; i < 4; ++i)
#pragma unroll
                for (int j = 0; j < 4; ++j) { const int pp = pc + 4 * i + j; const float cr = cr4[i][j], ci = ci4[i][j];
#pragma unroll
                    for (int e = 0; e < 4; ++e) acc[e] += cr * scr[pp * 33 + hq + e] - ci * scr[pp * 33 + 16 + hq + e]; }
        }
        bf16* kp = Kt + ((size_t)g * 32 + tau) * 256 + h * 16 + hq;
        *(unsigned long long*)kp = (unsigned long long)pk2(acc[0], acc[1]) | ((unsigned long long)pk2(acc[2], acc[3]) << 32);
        LDS_WAIT(); asm volatile("" ::: "memory");
    }
}

__device__ __forceinline__ int u_off(int token, int hbyte) { return ((token * 32 + hbyte) ^ (((token >> 5) & 15) << 4)); }
__device__ __forceinline__ int s_off(int c, int kbyte) { return ((c * 256 + kbyte) ^ ((c & 15) << 4)); }

__device__ __forceinline__ void s5_unit(const Frame& F, const P& p, LAS unsigned char* lds, int b, int g) {
    const bf16* Z = (const bf16*)(p.ws + WS_Z); bf16* YP = (bf16*)(p.ws + WS_YP);
    const bf16* Kt = (const bf16*)(p.ws + T_K) + (size_t)g * 32 * 256; const bf16* Qg = (const bf16*)(p.ws + T_Q) + (size_t)g * 128 * 512;
    const bf16* Pg = (const bf16*)(p.ws + T_P) + (size_t)g * 512 * 128; const float* A32 = (const float*)(p.ws + T_A) + (size_t)g * 128;
    const int tid = F.tid, lane = F.lane, wid = F.wave, r32 = lane & 31, hi = lane >> 5;
#pragma unroll
    for (int i = 0; i < 8; ++i) { const int id = tid + 512 * i, tok = id >> 1, half = id & 1;
        const v4u v = *(const v4u*)(Z + ((size_t)b * SEQ + tok) * NZ0 + g * 16 + half * 8);
        *(LAS v4u*)(lds + L_U + u_off(tok, half * 16)) = v; }
#pragma unroll
    for (int i = 0; i < 2; ++i) { const int id = tid + 512 * i; *(LAS v4u*)(lds + L_K + id * 16) = *(const v4u*)(Kt + id * 8); }
    LAS float* msc = (LAS float*)(lds + L_E);
    if (wid == 0) {
        Disc d; disc(p, g, lane, d);
        { const int s = lane >> 2, h4 = (lane & 3) * 4; const unsigned long long uu = *(const unsigned long long*)(Z + (size_t)(MX + s) * NZ0 + g * 16 + h4);
#pragma unroll
          for (int e = 0; e < 4; ++e) msc[s * 16 + h4 + e] = bf2f((bf16)((uu >> (16 * e)) & 0xffffu)); }
        if (b == 0) for (int i = lane; i < 1024; i += 64) { msc[512 + i] = p.in[I_CRE][(size_t)g * 1024 + i]; msc[512 + 1024 + i] = p.in[I_CIM][(size_t)g * 1024 + i]; }
        LDS_WAIT(); asm volatile("" ::: "memory");
        float hr = 0.f, hm = 0.f;
        for (int s = 0; s < NMETA; ++s) {
            float bur = 0.f, bui = 0.f;
#pragma unroll
            for (int h = 0; h < 16; ++h) { const float u = msc[s * 16 + h]; bur += u * d.bbr[h]; bui += u * d.bbi[h]; }
            const float nhr = d.ar * hr - d.ai * hm + bur, nhi = d.ar * hm + d.ai * hr + bui; hr = nhr; hm = nhi;
            if (b == 0) {
                msc[256 + lane] = hr; msc[320 + lane] = hm;
                LDS_WAIT(); asm volatile("" ::: "memory");
                const int h = lane >> 2, q = lane & 3; float y = 0.f;
                for (int pp = q * 16; pp < q * 16 + 16; ++pp) y += msc[256 + pp] * msc[512 + h * 64 + pp] - msc[320 + pp] * msc[512 + 1024 + h * 64 + pp];
                y += __shfl_xor(y, 1); y += __shfl_xor(y, 2);
                if (q == 0) { y += p.in[I_S5D][g * 16 + h] * msc[s * 16 + h]; YP[(size_t)(MX + s) * 512 + g * 16 + h] = f2bf(gelu_tanh(y)); }
                LDS_WAIT(); asm volatile("" ::: "memory");
            }
        }
        *(LAS bf16*)(lds + L_S + s_off(0, lane * 2)) = f2bf(hr); *(LAS bf16*)(lds + L_S + s_off(0, (64 + lane) * 2)) = f2bf(hm);
        msc[256 + lane] = hr; msc[320 + lane] = hm;
    }
    __syncthreads();
    float s0r = 0.f, s0i = 0.f;
    if (wid == 0) { s0r = msc[256 + lane]; s0i = msc[320 + lane]; }
    __syncthreads();
    {
        const int mt = wid & 3, nt = wid >> 2, c = 32 * nt + r32;
        f32x16 acc = f32x16{};
        const bf16* qa = Qg + (size_t)(32 * mt + r32) * 512 + hi * 8;
#pragma unroll
        for (int kh = 0; kh < 2; ++kh) {
            bf16x8 af[16];
#pragma unroll
            for (int k2 = 0; k2 < 16; ++k2) af[k2] = *(const bf16x8*)(qa + (16 * kh + k2) * 16);
#pragma unroll
            for (int k2 = 0; k2 < 16; ++k2) { const int ks = 16 * kh + k2;
                const bf16x8 bq = *(const LAS bf16x8*)(lds + L_U + u_off(32 * c + ks, hi * 16));
                acc = __builtin_amdgcn_mfma_f32_32x32x16_bf16(af[k2], bq, acc, 0, 0, 0); }
        }
        LAS float* E = (LAS float*)(lds + L_E);
#pragma unroll
        for (int r = 0; r < 16; ++r) E[c * 128 + 32 * mt + crow(r, hi)] = acc[r];
    }
    __syncthreads();
    if (wid == 0) {
        const float a32r = A32[lane * 2], a32i = A32[lane * 2 + 1];
        const LAS float* E = (const LAS float*)(lds + L_E);
        float sr = s0r, si = s0i;
        for (int c = 0; c < 63; ++c) {
            const float er = E[c * 128 + lane], ei = E[c * 128 + 64 + lane];
            const float nr = a32r * sr - a32i * si + er, ni = a32r * si + a32i * sr + ei; sr = nr; si = ni;
            *(LAS bf16*)(lds + L_S + s_off(c + 1, lane * 2)) = f2bf(sr); *(LAS bf16*)(lds + L_S + s_off(c + 1, (64 + lane) * 2)) = f2bf(si);
        }
    }
    __syncthreads();
#pragma unroll 1
    for (int q4 = 0; q4 < 4; ++q4) {
        const int i = (q4 & 1) ? 15 - wid : wid, nt = q4 >> 1, c = 32 * nt + r32;
        const int t = 2 * i + (r32 >> 4), h = r32 & 15;
        f32x16 acc = f32x16{};
        const bf16* pa = Pg + (size_t)(32 * i + r32) * 128 + hi * 8;
#pragma unroll
        for (int ks = 0; ks < 8; ++ks) {
            const bf16x8 a = *(const bf16x8*)(pa + ks * 16);
            const bf16x8 bq = *(const LAS bf16x8*)(lds + L_S + s_off(c, ks * 32 + hi * 16));
            acc = __builtin_amdgcn_mfma_f32_32x32x16_bf16(a, bq, acc, 0, 0, 0);
        }
#pragma unroll 2
        for (int s = 0; s <= 2 * i + 1; ++s) {
            const int tau = t - s;
            bf16x8 a = *(const LAS bf16x8*)(lds + L_K + ((tau < 0 ? 0 : tau) * 256 + h * 16 + hi * 8) * 2);
            if (tau < 0) a = (bf16x8){0, 0, 0, 0, 0, 0, 0, 0};
            const bf16x8 bq = *(const LAS bf16x8*)(lds + L_U + u_off(32 * c + s, hi * 16));
            acc = __builtin_amdgcn_mfma_f32_32x32x16_bf16(a, bq, acc, 0, 0, 0);
        }
#pragma unroll
        for (int rq = 0; rq < 4; ++rq) {
            const int tt = 2 * i + (rq >> 1), h0 = 8 * (rq & 1) + 4 * hi, tok = 32 * c + tt;
            const unsigned long long uu = *(const LAS unsigned long long*)(lds + L_U + u_off(tok, h0 * 2));
            const pg8::f32x4 dd = *(const pg8::f32x4*)(p.in[I_S5D] + g * 16 + h0);
            float y[4];
#pragma unroll
            for (int e = 0; e < 4; ++e) { const float u = bf2f((bf16)((uu >> (16 * e)) & 0xffffu)); y[e] = fast_gelu(acc[4 * rq + e] + dd[e] * u); }
            *(unsigned long long*)(YP + ((size_t)b * SEQ + tok) * 512 + g * 16 + h0) = (unsigned long long)pk2(y[0], y[1]) | ((unsigned long long)pk2(y[2], y[3]) << 32);
        }
    }
    __syncthreads();
}
__device__ __forceinline__ void s5_phase(const Frame& F, const P& p, LAS unsigned char* lds) {
#pragma unroll 1
    for (int u = F.vcu; u < 256; u += F.G) s5_unit(F, p, lds, u >> 5, u & 31);
}
}

typedef ArgsF Args;
typedef __attribute__((address_space(4))) const Args CArgs;
__device__ __forceinline__ void load_p(P& p, CArgs* q) {
    asm volatile("" : "+s"(q));
#pragma unroll
    for (int i = 0; i < 50; ++i) p.in[i] = q->p.in[i];
    p.out = q->p.out; p.ws = q->p.ws;
}

#ifndef PH_MASK
#define PH_MASK 0xFFFFFFFFu
#endif
#define IN(k) (((PH_MASK >> (k)) & 1u) && lo <= (k) && (k) < hi)
#define SEAM(k) do { if (IN(k) && IN((k) + 1)) xcd_barrier(bar); } while (0)
#ifndef REP_MASK
#define REP_MASK 0u
#endif
#ifndef REP_N
#define REP_N 2
#endif
#define REPS(k) for (int rep_ = 0; rep_ < ((((REP_MASK) >> (k)) & 1u) ? REP_N : 1); ++rep_, ((((REP_MASK) >> (k)) & 1u) && rep_ < REP_N ? xcd_barrier(bar) : (void)0))
template <int L> __device__ __forceinline__ void moe_gemm_phases(const Frame& F, CArgs* ap0, unsigned* ctl, volatile LAS unsigned* MISC, const XcdBarrier& bar, int lo, int hi) {
        const int ph = L ? 15 : 7;
        if (IN(ph)) REPS(ph) {
            P p; load_p(p, ap0);
            volatile LAS int* tp = (volatile LAS int*)(MISC + 16);
            const int* cnt = (const int*)ctl + (L ? CW_CNT1 : CW_CNT0);
            const int tiles = moe_prefix(cnt, tp, F.tid);
            MoeOrder<true, 4, 1024, 1024> S{(const char*)(p.ws + WS_HB), (const char*)(p.ws + (L ? WS_MOE1 : WS_MOE0) + MOE_WGU), (const int*)(p.ws + WS_ROUTE), cnt, tp, F.G, F.vcu, tiles * 4};
            FEpiMoe1 E{(bf16*)(p.ws + WS_YM)};
            pg8::gemm_phase<FEpiMoe1, MoeOrder<true, 4, 1024, 1024>, true>(F.lds, 1024, S, E);
        }
        SEAM(ph);
        if (IN(ph + 1)) REPS(ph + 1) {
            P p; load_p(p, ap0);
            volatile LAS int* tp = (volatile LAS int*)(MISC + 16);
            const int* cnt = (const int*)ctl + (L ? CW_CNT1 : CW_CNT0);
            const int tiles = moe_prefix(cnt, tp, F.tid);
            MoeOrder<false, 4, 512, 1024> S{(const char*)(p.ws + WS_YM), (const char*)(p.ws + (L ? WS_MOE1 : WS_MOE0) + MOE_WD), (const int*)(p.ws + WS_ROUTE), cnt, tp, F.G, F.vcu, tiles * 4};
            FEpiMoe2 E{(bf16*)(p.ws + WS_Z), (const int*)(p.ws + WS_ROUTE), (const float*)(p.ws + WS_GATE)};
            pg8::gemm_phase<FEpiMoe2, MoeOrder<false, 4, 512, 1024>, true>(F.lds, 512, S, E);
        }
        SEAM(ph + 1);
}
__global__ void __launch_bounds__(NWAVES * 64, 2) mk(Args args) {
    extern __shared__ __attribute__((aligned(16))) unsigned char lds_raw[];
    CArgs* ap0 = (CArgs*)__builtin_amdgcn_kernarg_segment_ptr();
    Frame F;
    F.lds = (LAS unsigned char*)lds_raw;
    F.tid = threadIdx.x; F.lane = F.tid & 63; F.wave = __builtin_amdgcn_readfirstlane(F.tid >> 6);
    F.G = gridDim.x; { const int bx = blockIdx.x; F.vcu = (F.G % 8 == 0) ? (bx % 8) * (F.G / 8) + bx / 8 : bx; }
    volatile LAS unsigned* MISC = (volatile LAS unsigned*)(F.lds + MISC_OFF);
    for (int u = F.tid; u < (LDS_BYTES - RING_BYTES) / 4; u += NWAVES * 64) ((LAS unsigned*)(F.lds + RING_BYTES))[u] = 0u;
    __syncthreads();
    unsigned* ctl = (unsigned*)(ap0->p.ws + WS_CTL);
    const bool multi = (ap0->ph_hi - ap0->ph_lo) > 1;
    XcdBarrier bar; bar.bar = ctl + CW_BAR + ap0->li * XCD_BAR_WORDS; bar.x = 0; bar.st = nullptr;
    if (multi) bar = xcd_barrier_post(ctl + CW_BAR + ap0->li * XCD_BAR_WORDS, MISC + 8);
    const int lo = ap0->ph_lo, hi = ap0->ph_hi;
    const int gw = F.vcu * NWAVES + F.wave, NGW = F.G * NWAVES;

#ifdef EXTRA_BARS
    if (multi) for (int eb = 0; eb < EXTRA_BARS; ++eb) xcd_barrier(bar);
#endif
    if (IN(0)) REPS(0) {
        P p; load_p(p, ap0);
        LAS float* scr = (LAS float*)(F.lds + F.wave * 16384);
#ifndef CVT_ABL
#define CVT_ABL 0
#endif
        cvt_range(ap0, gw, CI_SMALL + CI_MOE, NGW, scr, F.lane, (((REP_MASK >> 0) & 1u) && rep_ + 1 < REP_N) ? CVT_ABL : 0);
        const int abl0 = (((REP_MASK >> 0) & 1u) && rep_ + 1 < REP_N) ? CVT_ABL : 0;
        if (!(abl0 & 8)) { for (int it = gw; it < 32 * 33; it += NGW) s5::table_item(p, it / 33, it % 33, scr, F.lane);
        router_table(p, gw * 64 + F.lane, NGW * 64); }
        bf16* H0b = (bf16*)(p.ws + WS_R1);
        if (!(abl0 & 4)) for (int r = gw; r < MR; r += NGW) {
            const float* src = r < MX ? p.in[I_X] + (size_t)r * D : p.in[I_META] + (size_t)(r - MX) * D;
#pragma unroll
            for (int j = 0; j < 4; ++j) { const f32x4 v = *(const f32x4*)(src + j * 256 + F.lane * 4);
                *(unsigned long long*)(H0b + (size_t)r * D + j * 256 + F.lane * 4) = (unsigned long long)pk2(v[0], v[1]) | ((unsigned long long)pk2(v[2], v[3]) << 32); }
        }
    }
    SEAM(0);
    if (IN(1)) REPS(1) {
        P p; load_p(p, ap0);
        pg8::DenseOrder S; S.init(p.ws + WS_R1, p.ws + WB_WIN0, MX, NZ0, D, F.G, (int)blockIdx.x);
        FEpiZ0 E{(bf16*)(p.ws + WS_Z)};
        pg8::gemm_phase<FEpiZ0, pg8::DenseOrder, true>(F.lds, D, S, E);
        meta_gemm(F, p, (const bf16*)(p.ws + WS_R1) + (size_t)MX * D, D, (const bf16*)(p.ws + WB_WIN0), NZ0, D, EZ0{});
    }
    SEAM(1);

    if (IN(2)) REPS(2) { P p; load_p(p, ap0); s5::s5_phase(F, p, F.lds); }
#ifndef ATT_ABL
#define ATT_ABL 0
#endif
    if (IN(3)) REPS(3) { P p; load_p(p, ap0); att::attn_phase(F, p, F.lds, (((REP_MASK >> 3) & 1u) && rep_ + 1 < REP_N) ? ATT_ABL : 0); }
    SEAM(3);
    if (IN(4)) REPS(4) {
        P p; load_p(p, ap0);
        pg8::DenseOrder S; S.init(p.ws + WS_YP, p.ws + WB_WGLU, MX, 512, 512, F.G, (int)blockIdx.x);
        FEpiGLU E{(const bf16*)(p.ws + WS_YP), (bf16*)(p.ws + WS_YM), p.in[I_BGLU]};
        pg8::gemm_phase<FEpiGLU, pg8::DenseOrder, true>(F.lds, 512, S, E);
        meta_gemm(F, p, (const bf16*)(p.ws + WS_YP) + (size_t)MX * 512, 512, (const bf16*)(p.ws + WB_WGLU), 512, 512, EGLU{});
    }
    SEAM(4);
    if (IN(5)) REPS(5) {
        P p; load_p(p, ap0);
        pg8::DenseOrder S; S.init(p.ws + WS_YM, p.ws + WB_WOUT0, MX, D, D, F.G, (int)blockIdx.x);
        FEpiOut0 E{p.in[I_X], (bf16*)(p.ws + WS_R1)};
        pg8::gemm_phase<FEpiOut0, pg8::DenseOrder, true>(F.lds, D, S, E);
        meta_gemm(F, p, (const bf16*)(p.ws + WS_YM) + (size_t)MX * D, D, (const bf16*)(p.ws + WB_WOUT0), D, D, EOUT0{});
    }
    SEAM(5);
    if (IN(6)) { P p; load_p(p, ap0); router_phase<0>(F, p, gw, NGW, F.lds, ap0);
#ifdef ROUTER_FULL2
        xcd_barrier(bar); if (blockIdx.x == 0 && F.tid < 32) ((int*)ctl)[CW_CNT0 + CNT_IDX(F.tid)] = 0; xcd_barrier(bar); router_phase<0>(F, p, gw, NGW, F.lds, ap0);
#endif
    }
    SEAM(6);
    moe_gemm_phases<0>(F, ap0, ctl, MISC, bar, lo, hi);
    if (IN(9)) { P p; load_p(p, ap0); combine_phase<0>(F, p, gw, NGW); }
    SEAM(9);
    if (IN(10)) REPS(10) {
        P p; load_p(p, ap0);
        pg8::DenseOrder S; S.init(p.ws + WS_HB, p.ws + WB_WIN1, MX, NZ1, D, F.G, (int)blockIdx.x);
        FEpiZ1 E{(bf16*)(p.ws + WS_Z)};
        pg8::gemm_phase<FEpiZ1, pg8::DenseOrder, true>(F.lds, D, S, E);
        meta_gemm(F, p, (const bf16*)(p.ws + WS_HB) + (size_t)MX * D, D, (const bf16*)(p.ws + WB_WIN1), NZ1, D, EZ1{});
    }
    SEAM(10);
    if (IN(11)) REPS(11) { P p; load_p(p, ap0); lru::conv_phase(F, p); }
    SEAM(11);
    if (IN(12)) REPS(12) { P p; load_p(p, ap0);
        const bool scanner = (gw % 3 == 0) && gw < 1920;
        if (scanner) lru::scan_phase(F, p);
        else { const int rank = gw < 1920 ? gw - (gw / 3 + 1) : 1280 + (gw - 1920);
            cvt_range(ap0, CI_SMALL + CI_MOE + rank, CI_TOTAL, NGW - 640, (LAS float*)(F.lds + F.wave * 16384), F.lane); }
    }
    SEAM(12);
    if (IN(13)) REPS(13) {
        P p; load_p(p, ap0);
        pg8::DenseOrder S; S.init(p.ws + WS_YM, p.ws + WB_WOUT1, MX, D, DRNN, F.G, (int)blockIdx.x);
        FEpiOut1 E{(const bf16*)(p.ws + WS_HB), (bf16*)(p.ws + WS_R1)};
        pg8::gemm_phase<FEpiOut1, pg8::DenseOrder, true>(F.lds, DRNN, S, E);
        meta_gemm(F, p, (const bf16*)(p.ws + WS_YM) + (size_t)MX * DRNN, DRNN, (const bf16*)(p.ws + WB_WOUT1), D, DRNN, EOUT1{});
    }
    SEAM(13);
    if (IN(14)) { P p; load_p(p, ap0); router_phase<1>(F, p, gw, NGW, F.lds, ap0); }
    SEAM(14);
    moe_gemm_phases<1>(F, ap0, ctl, MISC, bar, lo, hi);
    if (IN(17)) { P p; load_p(p, ap0); combine_phase<1>(F, p, gw, NGW);
#ifdef COMBINE2
        xcd_barrier(bar); combine_phase<1>(F, p, gw, NGW);
#endif
    }

}

static int g_grid = 0;
static void launch_mk(const P& p, int lo, int hi, int li, hipStream_t stream) {
    Args a{}; a.p = p; a.ph_lo = lo; a.ph_hi = hi; a.li = li; a.pad = 0;
    hipLaunchKernelGGL(mk, dim3(g_grid), dim3(NWAVES * 64), LDS_BYTES, stream, a);
}
extern "C" void kernel_launch(void* const* d_in, const int* in_sizes, int n_in, void* d_out, int out_size, void* d_ws, size_t ws_size, hipStream_t stream) {
    if (n_in != 50 || ws_size < WS_END) { fprintf(stderr, "kernel_launch: unexpected n_in %d or ws %zu\n", n_in, ws_size); return; }
    if (g_grid == 0) {
        int dev = 0, cus = 0, per_cu = 0;
        (void)hipGetDevice(&dev); (void)hipDeviceGetAttribute(&cus, hipDeviceAttributeMultiprocessorCount, dev);
        if (hipFuncSetAttribute((const void*)mk, hipFuncAttributeMaxDynamicSharedMemorySize, LDS_BYTES) != hipSuccess) { fprintf(stderr, "hipFuncSetAttribute failed\n"); g_grid = -1; return; }
        if (hipOccupancyMaxActiveBlocksPerMultiprocessor(&per_cu, (const void*)mk, NWAVES * 64, LDS_BYTES) != hipSuccess || per_cu < 1) { fprintf(stderr, "occupancy query: %d\n", per_cu); }
        (void)hipGetLastError();
        g_grid = cus > 0 ? cus : 256;
    }
    if (g_grid < 0) return;
    P p{};
    for (int i = 0; i < 50; ++i) p.in[i] = (const float*)d_in[i];
    p.out = (float*)d_out; p.ws = (unsigned char*)d_ws;
    (void)hipMemsetAsync((char*)d_ws + WS_CTL, 0, 1 * MiB, stream);
    launch_mk(p, 0, 18, 0, stream);
}
```
